# Optimizing an MI355X kernel written in HIP

```python
import jax, jax.numpy as jnp
from jax import lax
import numpy as np

D_MODEL = 1024
BATCH = 2
SEQ = 8192
DEPTH = 4

N_MIXERS = 2
CONV_WIDTH = 3
CONV_GROUPS = 16
FOURIER_GROUPS = 8
FOURIER_GROUP_DIM = D_MODEL // FOURIER_GROUPS
D_FF = ((8 * D_MODEL // 3 + 255) // 256) * 256
N_CONV_LAYERS = (DEPTH + 1) // 2
N_FOURIER_LAYERS = DEPTH // 2
RMS_EPS = 1e-5

kernel_name = "hybrid_shortconv_fourier_encoder"


def rmsnorm(x, g):
    xf = x.astype(jnp.float32)
    r = lax.rsqrt(jnp.mean(xf * xf, axis=-1, keepdims=True) + RMS_EPS)
    return (xf * r * g.astype(jnp.float32)).astype(x.dtype)


def short_conv_mixer(h, w_in, k, w_out):
    bcv = jnp.einsum('bsd,de->bse', h, w_in)
    gate_b, gate_c, v = jnp.split(bcv, 3, axis=-1)
    u = gate_c * v
    up = jnp.pad(u, ((0, 0), (1, 1), (0, 0)))
    conv = k[0] * up[:, :-2] + k[1] * up[:, 1:-1] + k[2] * up[:, 2:]
    return jnp.einsum('bsd,de->bse', gate_b * conv, w_out)


def fourier_mixer(h, w_out):
    bsz, seq, dm = h.shape
    hf = h.astype(jnp.float32).reshape(bsz, seq, FOURIER_GROUPS, FOURIER_GROUP_DIM)
    f = jnp.fft.fft2(hf, axes=(1, 3), norm='ortho')
    y = jnp.real(f).astype(h.dtype).reshape(bsz, seq, dm)
    return jnp.einsum('bsd,de->bse', y, w_out)


def swiglu(h, w_gate, w_up, w_down):
    a = jnp.einsum('bsd,df->bsf', h, w_gate)
    b = jnp.einsum('bsd,df->bsf', h, w_up)
    return jnp.einsum('bsf,fd->bsd', jax.nn.silu(a) * b, w_down)


def setup_inputs(seed: int = 0) -> dict:
    key = jax.random.key(seed)
    ks = jax.random.split(key, 12)
    f32 = jnp.float32
    x = jax.random.normal(ks[0], (BATCH, SEQ, D_MODEL), f32)
    conv_w_in = jax.random.normal(ks[1], (N_CONV_LAYERS, D_MODEL, 3 * D_MODEL), f32) * D_MODEL ** -0.5
    conv_k = jax.random.normal(ks[2], (N_CONV_LAYERS, CONV_WIDTH, D_MODEL), f32) * CONV_WIDTH ** -0.5
    conv_w_out = jax.random.normal(ks[3], (N_CONV_LAYERS, D_MODEL, D_MODEL), f32) * D_MODEL ** -0.5
    fourier_w_out = jax.random.normal(ks[4], (N_FOURIER_LAYERS, D_MODEL, D_MODEL), f32) * D_MODEL ** -0.5
    mix_norm_g = 1.0 + 0.02 * jax.random.normal(ks[5], (DEPTH, D_MODEL), f32)
    ffn_norm_g = 1.0 + 0.02 * jax.random.normal(ks[6], (DEPTH, D_MODEL), f32)
    ffn_w_gate = jax.random.normal(ks[7], (DEPTH, D_MODEL, D_FF), f32) * D_MODEL ** -0.5
    ffn_w_up = jax.random.normal(ks[8], (DEPTH, D_MODEL, D_FF), f32) * D_MODEL ** -0.5
    ffn_w_down = jax.random.normal(ks[9], (DEPTH, D_FF, D_MODEL), f32) * D_FF ** -0.5
    final_norm_g = 1.0 + 0.02 * jax.random.normal(ks[10], (D_MODEL,), f32)
    return {
        'x': x,
        'conv_w_in': conv_w_in,
        'conv_k': conv_k,
        'conv_w_out': conv_w_out,
        'fourier_w_out': fourier_w_out,
        'mix_norm_g': mix_norm_g,
        'ffn_norm_g': ffn_norm_g,
        'ffn_w_gate': ffn_w_gate,
        'ffn_w_up': ffn_w_up,
        'ffn_w_down': ffn_w_down,
        'final_norm_g': final_norm_g,
    }


def reference(x, conv_w_in, conv_k, conv_w_out, fourier_w_out, mix_norm_g,
              ffn_norm_g, ffn_w_gate, ffn_w_up, ffn_w_down, final_norm_g):
    h = x
    for i in range(DEPTH):
        hn = rmsnorm(h, mix_norm_g[i])
        j = i // N_MIXERS
        if i % N_MIXERS == 0:
            h = h + short_conv_mixer(hn, conv_w_in[j], conv_k[j], conv_w_out[j])
        else:
            h = h + fourier_mixer(hn, fourier_w_out[j])
        hn = rmsnorm(h, ffn_norm_g[i])
        h = h + swiglu(hn, ffn_w_gate[i], ffn_w_up[i], ffn_w_down[i])
    return rmsnorm(h, final_norm_g)
```

```cpp
#include <hip/hip_runtime.h>
#include <cstdio>
#include <cstdint>
#ifndef MK_PER_PHASE
#define MK_PER_PHASE 0
#endif
namespace pg8 {
#define PG8_LAS __attribute__((address_space(3)))
typedef unsigned short bf16_t;
typedef short bf16x8 __attribute__((ext_vector_type(8)));
typedef float f32x4 __attribute__((ext_vector_type(4)));
typedef unsigned u32x4 __attribute__((ext_vector_type(4)));
constexpr int BM = 256, BK = 64, HALF = 128, HTB = HALF * BK * 2  , STAGE_BYTES = 8 * HTB, NXCD = 8, WGM = 8;

__host__ __device__ __forceinline__ int lds_byte(int r, int c) { const int st = (r >> 4) * 2 + (c >> 5), rr = r & 15, cc = c & 31, ob = rr * 64 + cc * 2; return st * 1024 + (ob ^ (((ob >> 9) & 1) << 5)); }
__host__ __device__ __forceinline__ void stage_rc(int b, int& R, int& C) { const int st = b / 1024, sb = b % 1024, swz = sb ^ (((sb >> 9) & 1) << 5); R = (st >> 1) * 16 + swz / 64; C = (st & 1) * 32 + (swz % 64) / 2; }
__host__ __device__ __forceinline__ int perm32(int rho) { const int n = rho >> 4, i = rho & 15; return 8 * (i >> 2) + 4 * n + (i & 3); }

struct Unit { int pm, pn; };
struct Gemm { const bf16_t* A; const bf16_t* Bt; int M, N, K; };

struct StaticOrder {
    int nM, nN, nwg, G, c;
    __host__ __device__ void init(int M, int N, int G_, int c_) { nM = M / BM; nN = N / BM; nwg = nM * nN; G = G_; c = c_; }
    __host__ __device__ bool next(int i, Unit& u) const {
        const long L = (long)i * G + c; if (L >= nwg) return false;
        int wgid = (int)L; { const int q = nwg / NXCD, r = nwg % NXCD, xcd = wgid % NXCD, off = wgid / NXCD; wgid = (xcd < r ? xcd * (q + 1) : r * (q + 1) + (xcd - r) * q) + off; }
        const int nig = WGM * nN, gid = wgid / nig, fm = gid * WGM, gsz = (nM - fm) < WGM ? (nM - fm) : WGM;
        u.pm = fm + ((wgid % nig) % gsz); u.pn = (wgid % nig) / gsz; return true;
    }
    __device__ __forceinline__ void a_ready(const Unit&) const {}
    __device__ __forceinline__ void done(const Unit&) const {}
};


typedef __bf16 bf16x2_t __attribute__((ext_vector_type(2)));
typedef float f32x2_t __attribute__((ext_vector_type(2)));
__device__ __forceinline__ unsigned cvt_pk_bf16(float lo, float hi) { f32x2_t v = {lo, hi}; bf16x2_t b = __builtin_convertvector(v, bf16x2_t); return __builtin_bit_cast(unsigned, b); }
constexpr float RMS_EPS = 1e-5f;
__device__ __forceinline__ float ld_agent(const float* p) { return *p; }
__device__ __forceinline__ float row_rs(const float* ssq, int row, int fq) {
    const float* p = ssq + (size_t)(4 * fq) * 16384 + row;
    float s = (ld_agent(p) + ld_agent(p + 16384)) + (ld_agent(p + 2 * 16384) + ld_agent(p + 3 * 16384));
    s += __shfl_xor(s, 16); s += __shfl_xor(s, 32);
    return __builtin_amdgcn_rsqf(s * (1.0f / 1024.0f) + RMS_EPS);
}
__device__ __forceinline__ void row_rs8(const float* ssq, int row0, int fq, float (&rr)[2][4]) {
    float v[2][4][4];
#pragma unroll
    for (int ai = 0; ai < 2; ++ai)
#pragma unroll
        for (int m = 0; m < 4; ++m) { const float* p = ssq + (size_t)(4 * fq) * 16384 + row0 + ai * HALF + m * 16;
#pragma unroll
            for (int k = 0; k < 4; ++k) v[ai][m][k] = ld_agent(p + k * 16384); }
#pragma unroll
    for (int ai = 0; ai < 2; ++ai)
#pragma unroll
        for (int m = 0; m < 4; ++m) { float s = (v[ai][m][0] + v[ai][m][1]) + (v[ai][m][2] + v[ai][m][3]);
            s += __shfl_xor(s, 16); s += __shfl_xor(s, 32); rr[ai][m] = __builtin_amdgcn_rsqf(s * (1.0f / 1024.0f) + RMS_EPS); }
}
__device__ __forceinline__ float bf_lo(unsigned w) { return __builtin_bit_cast(float, w << 16); }
__device__ __forceinline__ float bf_hi(unsigned w) { return __builtin_bit_cast(float, w & 0xffff0000u); }
struct EpiConvFused {
    static constexpr bool PERM = true, AFTER_DRAIN = false, ROWSCALE = false;
    bf16_t* U; bf16_t* Z; bf16_t* HZ; bf16_t* HBg; const float* ssq; const float* taps;
    __device__ __forceinline__ void operator()(const f32x4 (&acc)[2][2][4][2], const Unit& u, int wr, int wc, int fr, int fq) const {
        const int row0 = u.pm * BM + wr * 64 + fr; float rr[2][4]; row_rs8(ssq, row0, fq, rr);
        if (u.pn < 8) {
            const int col0 = (2 * (u.pn & 3) + (u.pn >> 2)) * 128 + wc * 32 + 8 * fq;
#pragma unroll
            for (int ai = 0; ai < 2; ++ai)
#pragma unroll
                for (int m = 0; m < 4; ++m) { const int row = row0 + ai * HALF + m * 16; const float r = rr[ai][m], r2 = r * r;
                    const f32x4 v0 = acc[ai][0][m][0] * acc[ai][1][m][0] * r2, v1 = acc[ai][0][m][1] * acc[ai][1][m][1] * r2;
                    u32x4 w; w.x = cvt_pk_bf16(v0[0], v0[1]); w.y = cvt_pk_bf16(v0[2], v0[3]); w.z = cvt_pk_bf16(v1[0], v1[1]); w.w = cvt_pk_bf16(v1[2], v1[3]);
                    *(u32x4*)(U + (size_t)row * 1024 + col0) = w; }
            asm volatile("s_waitcnt vmcnt(0)" ::: "memory");
        } else {
            asm volatile("s_waitcnt vmcnt(0)" ::: "memory");
#pragma unroll
            for (int bj = 0; bj < 2; ++bj) {
                const int col = (u.pn - 8) * BM + bj * HALF + wc * 32 + 8 * fq;
                const f32x4 k0a = *(const f32x4*)(taps + col), k0b = *(const f32x4*)(taps + col + 4), k1a = *(const f32x4*)(taps + 1024 + col), k1b = *(const f32x4*)(taps + 1024 + col + 4),
                            k2a = *(const f32x4*)(taps + 2048 + col), k2b = *(const f32x4*)(taps + 2048 + col + 4);
#pragma unroll
                for (int ai = 0; ai < 2; ++ai)
#pragma unroll
                    for (int m = 0; m < 4; ++m) { const int row = row0 + ai * HALF + m * 16, sq = row & 8191, lr = row & 255; const float r = rr[ai][m];
                        const bool up_in = lr != 0, dn_in = lr != 255, up_halo = !up_in && sq != 0, dn_halo = !dn_in && sq != 8191;
                        const bf16_t* up = U + (size_t)row * 1024 + col; const u32x4 z0 = {0u, 0u, 0u, 0u};
                        const u32x4 uc = *(const u32x4*)up, ul = up_in ? *(const u32x4*)(up - 1024) : z0, ur = dn_in ? *(const u32x4*)(up + 1024) : z0;
                        const f32x4 b0 = acc[ai][bj][m][0] * r, b1 = acc[ai][bj][m][1] * r;
                        u32x4 w;
                        w.x = cvt_pk_bf16(b0[0] * (k0a[0] * bf_lo(ul.x) + k1a[0] * bf_lo(uc.x) + k2a[0] * bf_lo(ur.x)), b0[1] * (k0a[1] * bf_hi(ul.x) + k1a[1] * bf_hi(uc.x) + k2a[1] * bf_hi(ur.x)));
                        w.y = cvt_pk_bf16(b0[2] * (k0a[2] * bf_lo(ul.y) + k1a[2] * bf_lo(uc.y) + k2a[2] * bf_lo(ur.y)), b0[3] * (k0a[3] * bf_hi(ul.y) + k1a[3] * bf_hi(uc.y) + k2a[3] * bf_hi(ur.y)));
                        w.z = cvt_pk_bf16(b1[0] * (k0b[0] * bf_lo(ul.z) + k1b[0] * bf_lo(uc.z) + k2b[0] * bf_lo(ur.z)), b1[1] * (k0b[1] * bf_hi(ul.z) + k1b[1] * bf_hi(uc.z) + k2b[1] * bf_hi(ur.z)));
                        w.w = cvt_pk_bf16(b1[2] * (k0b[2] * bf_lo(ul.w) + k1b[2] * bf_lo(uc.w) + k2b[2] * bf_lo(ur.w)), b1[3] * (k0b[3] * bf_hi(ul.w) + k1b[3] * bf_hi(uc.w) + k2b[3] * bf_hi(ur.w)));
                        if (up_halo || dn_halo) { const size_t ho = (size_t)(2 * u.pm + (dn_halo ? 1 : 0)) * 1024 + col;
                            u32x4 bw; bw.x = cvt_pk_bf16(b0[0], b0[1]); bw.y = cvt_pk_bf16(b0[2], b0[3]); bw.z = cvt_pk_bf16(b1[0], b1[1]); bw.w = cvt_pk_bf16(b1[2], b1[3]);
                            *(u32x4*)(HZ + ho) = w; *(u32x4*)(HBg + ho) = bw; }
                        else *(u32x4*)(Z + (size_t)row * 1024 + col) = w; }
            }
        }
    }
};
__device__ __forceinline__ float silu_mul(float a, float b) { return a * b * __builtin_amdgcn_rcpf(1.0f + __builtin_amdgcn_exp2f(a * -1.4426950408889634f)); }
struct EpiSwiGLU {
    static constexpr bool PERM = true, AFTER_DRAIN = false, ROWSCALE = true;
    bf16_t* O; int ldc; const float* ssq;
    __device__ __forceinline__ void operator()(const f32x4 (&acc)[2][2][4][2], const Unit& u, int wr, int wc, int fr, int fq, const float (&rr)[2][4]) const {
        const int row0 = u.pm * BM + wr * 64 + fr, col0 = u.pn * 128 + wc * 32 + 8 * fq;
#pragma unroll
        for (int ai = 0; ai < 2; ++ai)
#pragma unroll
            for (int m = 0; m < 4; ++m) { const int row = row0 + ai * HALF + m * 16; const float r = rr[ai][m];
                const f32x4 g0 = acc[ai][0][m][0] * r, g1 = acc[ai][0][m][1] * r, u0 = acc[ai][1][m][0] * r, u1 = acc[ai][1][m][1] * r;
                u32x4 w; w.x = cvt_pk_bf16(silu_mul(g0[0], u0[0]), silu_mul(g0[1], u0[1])); w.y = cvt_pk_bf16(silu_mul(g0[2], u0[2]), silu_mul(g0[3], u0[3]));
                w.z = cvt_pk_bf16(silu_mul(g1[0], u1[0]), silu_mul(g1[1], u1[1])); w.w = cvt_pk_bf16(silu_mul(g1[2], u1[2]), silu_mul(g1[3], u1[3]));
                *(u32x4*)(O + (size_t)row * ldc + col0) = w; }
    }
};
struct EpiScale {
    static constexpr bool PERM = true, AFTER_DRAIN = false, ROWSCALE = false;
    bf16_t* O; int ldc; const float* ssq;
    __device__ __forceinline__ void operator()(const f32x4 (&acc)[2][2][4][2], const Unit& u, int wr, int wc, int fr, int fq) const {
        const int row0 = u.pm * BM + wr * 64 + fr, col0 = u.pn * BM + wc * 32 + 8 * fq; float rr[2][4]; row_rs8(ssq, row0, fq, rr);
#pragma unroll
        for (int ai = 0; ai < 2; ++ai)
#pragma unroll
            for (int m = 0; m < 4; ++m) { const int row = row0 + ai * HALF + m * 16; const float r = rr[ai][m];
#pragma unroll
                for (int bj = 0; bj < 2; ++bj) { const f32x4 v0 = acc[ai][bj][m][0] * r, v1 = acc[ai][bj][m][1] * r;
                    u32x4 w; w.x = cvt_pk_bf16(v0[0], v0[1]); w.y = cvt_pk_bf16(v0[2], v0[3]); w.z = cvt_pk_bf16(v1[0], v1[1]); w.w = cvt_pk_bf16(v1[2], v1[3]);
                    *(u32x4*)(O + (size_t)row * ldc + col0 + bj * HALF) = w; } }
    }
};
struct EpiResid {
    static constexpr bool PERM = false, AFTER_DRAIN = false, ROWSCALE = false;
    bf16_t* hb; float* ssq;
    __device__ __forceinline__ void operator()(const f32x4 (&acc)[2][2][4][2], const Unit& u, int wr, int wc, int fr, int fq) const {
        typedef unsigned u32x2v __attribute__((ext_vector_type(2)));
        const int row0 = u.pm * BM + wr * 64 + fr, col0 = u.pn * BM + wc * 32 + 4 * fq;
        u32x2v bs[2][4][2][2];
#pragma unroll
        for (int ai = 0; ai < 2; ++ai)
#pragma unroll
            for (int m = 0; m < 4; ++m)
#pragma unroll
                for (int bj = 0; bj < 2; ++bj)
#pragma unroll
                    for (int n = 0; n < 2; ++n) bs[ai][m][bj][n] = *(const u32x2v*)(hb + (size_t)(row0 + ai * HALF + m * 16) * 1024 + col0 + bj * HALF + n * 16);
#pragma unroll
        for (int ai = 0; ai < 2; ++ai)
#pragma unroll
            for (int m = 0; m < 4; ++m) { const int row = row0 + ai * HALF + m * 16; const size_t off = (size_t)row * 1024 + col0; float q = 0.f;
#pragma unroll
                for (int bj = 0; bj < 2; ++bj)
#pragma unroll
                    for (int n = 0; n < 2; ++n) { const size_t o2 = off + bj * HALF + n * 16; const u32x2v b = bs[ai][m][bj][n];
                        const f32x4 bf = {__builtin_bit_cast(float, b.x << 16), __builtin_bit_cast(float, b.x & 0xffff0000u), __builtin_bit_cast(float, b.y << 16), __builtin_bit_cast(float, b.y & 0xffff0000u)};
                        const f32x4 o = bf + acc[ai][bj][m][n];
                        u32x2v w; w.x = cvt_pk_bf16(o[0], o[1]); w.y = cvt_pk_bf16(o[2], o[3]); *(u32x2v*)(hb + o2) = w;
                        q += (o[0] * o[0] + o[1] * o[1]) + (o[2] * o[2] + o[3] * o[3]); }
                q += __shfl_xor(q, 16); q += __shfl_xor(q, 32);
                if (fq == 0) ssq[(size_t)(4 * u.pn + wc) * 16384 + row] = q; }
    }
};
template <class Epi, class Sched, bool ALIGN_EPI = false, bool SP2 = false, int LDA = 0, int ACOL = 0>
__device__ __forceinline__ void gemm_phase(PG8_LAS unsigned char* lds, const Gemm g, const Sched& S, const Epi& E) {
    int tid_l = threadIdx.x; asm volatile("" : "+v"(tid_l));
    const int tid = tid_l, wid = __builtin_amdgcn_readfirstlane(tid >> 6), lane = tid & 63, wr = wid >> 2, wc = wid & 3, fr = lane & 15, fq = lane >> 4;
    int K_l = g.K; asm volatile("" : "+s"(K_l));
    const int K = K_l, nt = K / BK;
    const bf16_t* gA = g.A; const bf16_t* gB = g.Bt; asm volatile("" : "+s"(gA), "+s"(gB));
    unsigned voffA[2], voffB[2];
#pragma unroll
    for (int i = 0; i < 2; ++i) { int R, C; stage_rc(tid * 16 + i * 8192, R, C); const int Rb = Epi::PERM ? ((R & ~31) + perm32(R & 31)) : R;
        voffA[i] = (unsigned)(R * (LDA ? LDA : K) + C) * 2u; voffB[i] = (unsigned)(Rb * K + C) * 2u; }
    const size_t kstep = (size_t)(BK * 2);
    const size_t hstepB = (size_t)HALF * K * 2, hstepA = LDA ? (size_t)HALF * LDA * 2 : hstepB;
    const size_t tstepA = 2 * hstepA, tstepB = 2 * hstepB; constexpr size_t acolB = (size_t)ACOL * 2;
    const unsigned ldsw = (unsigned)wid * 1024u;
    const int aoff = lds_byte(wr * 64 + fr, fq * 8), boff = lds_byte(wc * 32 + fr, fq * 8);
#define PG8_SA(b, h) (((b) * 2 + (h)) * HTB)
#define PG8_SB(b, h) ((4 + (b) * 2 + (h)) * HTB)
#define PG8_STAGE(bufoff, gbase, voff) do { _Pragma("unroll") for (int _i = 0; _i < 2; ++_i) \
        __builtin_amdgcn_global_load_lds((const unsigned*)((const char*)(gbase) + (voff)[_i]), (PG8_LAS unsigned*)(lds + (bufoff) + ldsw + _i * 8192), 16, 0, 0); } while (0)
#define PG8_LDA(dst, b, h) do { _Pragma("unroll") for (int m = 0; m < 4; ++m) _Pragma("unroll") for (int k = 0; k < 2; ++k) dst[m][k] = *(const PG8_LAS bf16x8*)(lds + PG8_SA(b, h) + aoff + m * 2048 + k * 1024); } while (0)
#define PG8_LDB(dst, b, h) do { _Pragma("unroll") for (int n = 0; n < 2; ++n) _Pragma("unroll") for (int k = 0; k < 2; ++k) dst[n][k] = *(const PG8_LAS bf16x8*)(lds + PG8_SB(b, h) + boff + n * 2048 + k * 1024); } while (0)
#define PG8_MMA(ai, bj, At, Bt) do { __builtin_amdgcn_s_setprio(1); _Pragma("unroll") for (int m = 0; m < 4; ++m) _Pragma("unroll") for (int n = 0; n < 2; ++n) _Pragma("unroll") for (int k = 0; k < 2; ++k) \
        acc[ai][bj][m][n] = __builtin_amdgcn_mfma_f32_16x16x32_bf16(Bt[n][k], At[m][k], acc[ai][bj][m][n], 0, 0, 0); __builtin_amdgcn_s_setprio(0); } while (0)
#define PG8_WAIT_V(n) asm volatile("s_waitcnt vmcnt(" #n ")" ::: "memory")
#define PG8_WAIT_L(n) asm volatile("s_waitcnt lgkmcnt(" #n ")" ::: "memory")
#define PG8_BAR __builtin_amdgcn_s_barrier()
#define PG8_SCHED __builtin_amdgcn_sched_barrier(0)
    Unit cur, nxt; int ui = 0;
    if (!S.next(0, cur)) return;
    f32x4 acc[2][2][4][2];
#pragma unroll
    for (int a = 0; a < 2; ++a)
#pragma unroll
        for (int b = 0; b < 2; ++b)
#pragma unroll
            for (int m = 0; m < 4; ++m)
#pragma unroll
                for (int n = 0; n < 2; ++n) acc[a][b][m][n] = (f32x4){0.f, 0.f, 0.f, 0.f};
    bf16x8 At[4][2], B0[2][2], B1[2][2];
    typedef __fp16 h16x2 __attribute__((ext_vector_type(2)));
    h16x2 rrp[4];
    if constexpr (Epi::ROWSCALE) { float rr0[2][4]; row_rs8(E.ssq, cur.pm * BM + wr * 64 + fr, fq, rr0);
#pragma unroll
        for (int m = 0; m < 4; ++m) rrp[m] = __builtin_amdgcn_cvt_pkrtz(rr0[0][m], rr0[1][m]); }
    const char* cA = (const char*)gA + (size_t)cur.pm * tstepA + (size_t)cur.pn * acolB; const char* cB = (const char*)gB + (size_t)cur.pn * tstepB;
    S.a_ready(cur);
    if constexpr (SP2) {
        PG8_STAGE(PG8_SB(0, 0), cB, voffB); PG8_STAGE(PG8_SB(0, 1), cB + hstepB, voffB); PG8_STAGE(PG8_SA(0, 0), cA, voffA); PG8_STAGE(PG8_SA(0, 1), cA + hstepA, voffA);
        if (wr == 1) PG8_BAR;
        PG8_WAIT_V(2); PG8_BAR;
        PG8_STAGE(PG8_SB(1, 0), cB + kstep, voffB); PG8_STAGE(PG8_SA(1, 0), cA + kstep, voffA); PG8_STAGE(PG8_SB(1, 1), cB + hstepB + kstep, voffB);
        PG8_WAIT_V(6); PG8_BAR;
    } else {
        PG8_STAGE(PG8_SB(0, 0), cB, voffB); PG8_STAGE(PG8_SA(0, 0), cA, voffA); PG8_STAGE(PG8_SB(0, 1), cB + hstepB, voffB); PG8_STAGE(PG8_SA(0, 1), cA + hstepA, voffA);
        if (wr == 1) PG8_BAR;
        PG8_WAIT_V(4); PG8_BAR;
        PG8_STAGE(PG8_SB(1, 0), cB + kstep, voffB); PG8_STAGE(PG8_SA(1, 0), cA + kstep, voffA); PG8_STAGE(PG8_SB(1, 1), cB + hstepB + kstep, voffB);
        PG8_WAIT_V(6); PG8_BAR;
    }
    for (;;) {
        const bool has_next = S.next(ui + 1, nxt);
        const char* nA = has_next ? (const char*)gA + (size_t)nxt.pm * tstepA + (size_t)nxt.pn * acolB : cA; const char* nB = has_next ? (const char*)gB + (size_t)nxt.pn * tstepB : cB;
        for (int t = 0; t < nt; t += 2) {
            const bool last = (t == nt - 2);
            const char* a1 = cA + (size_t)(t + 1) * kstep;
            const char* a2 = last ? nA : cA + (size_t)(t + 2) * kstep; const char* b2 = last ? nB : cB + (size_t)(t + 2) * kstep;
            const char* a3 = a2 + kstep; const char* b3 = b2 + kstep;
            if (last && has_next) S.a_ready(nxt);
            if constexpr (SP2) {
            PG8_LDB(B0, 0, 0); PG8_LDB(B1, 0, 1); PG8_SCHED; PG8_LDA(At, 0, 0); PG8_STAGE(PG8_SA(1, 1), a1 + hstepA, voffA);
            PG8_WAIT_V(8); PG8_WAIT_L(0); PG8_BAR; PG8_MMA(0, 0, At, B0); PG8_MMA(0, 1, At, B1); PG8_BAR; PG8_SCHED;
            PG8_LDA(At, 0, 1); PG8_STAGE(PG8_SB(0, 0), b2, voffB); PG8_STAGE(PG8_SB(0, 1), b2 + hstepB, voffB); PG8_STAGE(PG8_SA(0, 0), a2, voffA);
            PG8_WAIT_V(8); PG8_WAIT_L(0); PG8_BAR; PG8_MMA(1, 0, At, B0); PG8_MMA(1, 1, At, B1); PG8_BAR; PG8_SCHED;
            PG8_LDB(B0, 1, 0); PG8_LDB(B1, 1, 1); PG8_SCHED; PG8_LDA(At, 1, 0); PG8_STAGE(PG8_SA(0, 1), a2 + hstepA, voffA);
            PG8_WAIT_V(8); PG8_WAIT_L(0); PG8_BAR; PG8_MMA(0, 0, At, B0); PG8_MMA(0, 1, At, B1); PG8_BAR; PG8_SCHED;
            PG8_LDA(At, 1, 1); PG8_STAGE(PG8_SB(1, 0), b3, voffB); PG8_STAGE(PG8_SB(1, 1), b3 + hstepB, voffB); PG8_STAGE(PG8_SA(1, 0), a3, voffA);
            PG8_WAIT_V(8); PG8_WAIT_L(0); PG8_BAR; PG8_MMA(1, 0, At, B0); PG8_MMA(1, 1, At, B1); PG8_BAR; PG8_SCHED;
            } else {
            PG8_LDB(B0, 0, 0); PG8_SCHED; PG8_LDA(At, 0, 0); PG8_STAGE(PG8_SA(1, 1), a1 + hstepA, voffA);
            PG8_WAIT_L(8); PG8_BAR; PG8_WAIT_L(0); PG8_MMA(0, 0, At, B0); PG8_BAR; PG8_SCHED;
            PG8_LDB(B1, 0, 1); PG8_STAGE(PG8_SB(0, 0), b2, voffB);
            PG8_BAR; PG8_WAIT_L(0); PG8_MMA(0, 1, At, B1); PG8_BAR;
            PG8_LDA(At, 0, 1); PG8_STAGE(PG8_SA(0, 0), a2, voffA);
            PG8_BAR; PG8_WAIT_L(0); PG8_MMA(1, 0, At, B0); PG8_BAR; PG8_SCHED;
            PG8_STAGE(PG8_SB(0, 1), b2 + hstepB, voffB);
            PG8_WAIT_V(6); PG8_BAR; PG8_MMA(1, 1, At, B1); PG8_BAR;
            PG8_LDB(B0, 1, 0); PG8_SCHED; PG8_LDA(At, 1, 0); PG8_STAGE(PG8_SA(0, 1), a2 + hstepA, voffA);
            PG8_WAIT_L(8); PG8_BAR; PG8_WAIT_L(0); PG8_MMA(0, 0, At, B0); PG8_BAR; PG8_SCHED;
            PG8_LDB(B1, 1, 1); PG8_STAGE(PG8_SB(1, 0), b3, voffB);
            PG8_BAR; PG8_WAIT_L(0); PG8_MMA(0, 1, At, B1); PG8_BAR;
            PG8_LDA(At, 1, 1); PG8_STAGE(PG8_SA(1, 0), a3, voffA);
            PG8_BAR; PG8_WAIT_L(0); PG8_MMA(1, 0, At, B0); PG8_BAR; PG8_SCHED;
            PG8_STAGE(PG8_SB(1, 1), b3 + hstepB, voffB);
            PG8_WAIT_V(6); PG8_BAR; PG8_MMA(1, 1, At, B1); PG8_BAR;
            }
        }
        if constexpr (ALIGN_EPI) { if (wr == 0) PG8_BAR; }
        if constexpr (!Epi::AFTER_DRAIN) {
            int fr_e = fr; asm volatile("" : "+v"(fr_e));
            if constexpr (Epi::ROWSCALE) { float rrs[2][4];
#pragma unroll
                for (int m = 0; m < 4; ++m) { unsigned pk = __builtin_bit_cast(unsigned, rrp[m]); asm volatile("" : "+v"(pk)); const h16x2 hp = __builtin_bit_cast(h16x2, pk); rrs[0][m] = (float)hp[0]; rrs[1][m] = (float)hp[1]; }
                E(acc, cur, wr, wc, fr_e, fq, rrs); } else E(acc, cur, wr, wc, fr_e, fq); S.done(cur); }
        if (!has_next) break;
#pragma unroll
        for (int a = 0; a < 2; ++a)
#pragma unroll
            for (int b = 0; b < 2; ++b)
#pragma unroll
                for (int m = 0; m < 4; ++m)
#pragma unroll
                    for (int n = 0; n < 2; ++n) acc[a][b][m][n] = (f32x4){0.f, 0.f, 0.f, 0.f};
        cur = nxt; cA = nA; cB = nB; ++ui;
        if constexpr (ALIGN_EPI) { if (wr == 1) PG8_BAR; }
    }
    PG8_WAIT_V(0);
    if constexpr (!ALIGN_EPI) { if (wr == 0) PG8_BAR; }
    PG8_BAR;
    if constexpr (Epi::AFTER_DRAIN) { E.fused(acc, cur, wr, wc, fr, fq, lds, wid, lane); S.done(cur); }
#undef PG8_SA
#undef PG8_SB
#undef PG8_STAGE
#undef PG8_LDA
#undef PG8_LDB
#undef PG8_MMA
#undef PG8_WAIT_V
#undef PG8_WAIT_L
#undef PG8_BAR
#undef PG8_SCHED
}
}

constexpr int NWAVES = 8;
constexpr int BATCH = 2, SEQ = 8192, D = 1024, FF = 2816, DEPTH = 4;
constexpr int M = BATCH * SEQ;
constexpr int N_PHASES = 2 + 6 * DEPTH;

constexpr size_t MiB = 1u << 20;
constexpr size_t WS_CTL = 0, CTL_ZERO_BYTES = 64 * 1024;
constexpr size_t WS_SSQ = 1 * MiB;
constexpr size_t WS_WCT = 2 * MiB;
constexpr size_t WS_WIN = 4 * MiB;
constexpr size_t WS_WCO = 16 * MiB;
constexpr size_t WS_WFO = 20 * MiB;
constexpr size_t WS_WGU = 24 * MiB;
constexpr size_t WS_WD  = 68 * MiB;
constexpr size_t WS_HB  = 90 * MiB;
constexpr size_t WS_ZY  = 122 * MiB;
constexpr size_t WS_ACT = 154 * MiB;
constexpr size_t WS_WC2 = 242 * MiB;
constexpr size_t WS_HALO = 250 * MiB;
constexpr size_t WS_END = 251 * MiB;
constexpr int CW_BAR = 4096;

constexpr int RING_OFF = 0, RING_BYTES = 131072;
constexpr int FFT_BYTES = 135424;
constexpr int LDSCTL_OFF = 139264, MISC_OFF = LDSCTL_OFF + 320;
constexpr int LDS_BYTES = 155648;

#define GAS __attribute__((address_space(1)))
#define LAS __attribute__((address_space(3)))
typedef unsigned short bf16;
typedef unsigned v4u __attribute__((ext_vector_type(4)));
typedef unsigned v2u __attribute__((ext_vector_type(2)));
typedef float f32x4 __attribute__((ext_vector_type(4)));
typedef float f32x16 __attribute__((ext_vector_type(16)));
typedef short bf16x8 __attribute__((ext_vector_type(8)));
typedef GAS unsigned gu32;
#define RLX_AGENT __ATOMIC_RELAXED, __HIP_MEMORY_SCOPE_AGENT
#define LDS_WAIT() asm volatile("s_waitcnt lgkmcnt(0)" ::: "memory")
#define VM_WAIT() asm volatile("s_waitcnt vmcnt(0)" ::: "memory")
__device__ __forceinline__ unsigned f2bf(float f) { unsigned u = __builtin_bit_cast(unsigned, f); return (u + 0x7fffu + ((u >> 16) & 1u)) >> 16; }
__device__ __forceinline__ unsigned pk2(float lo, float hi) { return f2bf(lo) | (f2bf(hi) << 16); }
__device__ __forceinline__ float bflo(unsigned w) { return __builtin_bit_cast(float, w << 16); }
__device__ __forceinline__ float bfhi(unsigned w) { return __builtin_bit_cast(float, w & 0xffff0000u); }
__device__ __forceinline__ v4u ld16_agent(const void* p) { const unsigned long long* q = (const unsigned long long*)p;
    const unsigned long long a = __hip_atomic_load(q, __ATOMIC_RELAXED, __HIP_MEMORY_SCOPE_AGENT), b = __hip_atomic_load(q + 1, __ATOMIC_RELAXED, __HIP_MEMORY_SCOPE_AGENT);
    return (v4u){(unsigned)a, (unsigned)(a >> 32), (unsigned)b, (unsigned)(b >> 32)}; }
#define MFMA32(a, b, c) __builtin_amdgcn_mfma_f32_32x32x16_bf16((a), (b), (c), 0, 0, 0)
__device__ __forceinline__ bf16x8 pack_step(const f32x16& x, int s) {
    v4u p; p.x = pg8::cvt_pk_bf16(x[8 * s], x[8 * s + 1]); p.y = pg8::cvt_pk_bf16(x[8 * s + 2], x[8 * s + 3]); p.z = pg8::cvt_pk_bf16(x[8 * s + 4], x[8 * s + 5]); p.w = pg8::cvt_pk_bf16(x[8 * s + 6], x[8 * s + 7]);
    return __builtin_bit_cast(bf16x8, p);
}

#define XB_TMO      128
#define XB_XCNT(j)  (256  + 64 * (j))
#define XB_XSUB(j)  (1280 + 64 * (j))
#define XB_XGEN(j)  (2304 + 64 * (j))
#define XB_TOP      3328
#define XB_TOPGEN   3392
#define XCD_BAR_WORDS 3456
#define XB_SPIN_CAP (1u << 18)

__device__ __forceinline__ unsigned xb_ld(unsigned* p)              { return __hip_atomic_load(p, __ATOMIC_RELAXED, __HIP_MEMORY_SCOPE_AGENT); }
__device__ __forceinline__ unsigned xb_add(unsigned* p, unsigned v) { return __hip_atomic_fetch_add(p, v, __ATOMIC_RELAXED, __HIP_MEMORY_SCOPE_AGENT); }
__device__ __forceinline__ unsigned xb_xcc_id() { return (unsigned)__builtin_amdgcn_s_getreg((3 << 11) | 20) & 0xFu; }
#define XB_SPIN(cond, bar) do { unsigned _sp = 0; while (cond) { __builtin_amdgcn_s_sleep(1); \
    if ((++_sp & 255u) == 0u) { if (xb_ld(&(bar)[XB_TMO])) break; if (_sp > XB_SPIN_CAP) { atomicAdd(&(bar)[XB_TMO], 1u); break; } } } } while (0)

struct XcdBarrier {
    unsigned* bar; unsigned x;
    volatile LAS unsigned* st;
};

__device__ __forceinline__ XcdBarrier xcd_barrier_post(unsigned* bar, volatile LAS unsigned* st) {
    XcdBarrier b; b.bar = bar; b.x = xb_xcc_id(); b.st = st;
    if (threadIdx.x == 0) (void)xb_add(&bar[XB_XCNT(b.x)], 1u);
    return b;
}
__device__ __forceinline__ void xcd_barrier_complete(unsigned* bar, unsigned x, unsigned& nloc, unsigned& nx) {
    const unsigned G = gridDim.x * gridDim.y * gridDim.z;
    unsigned sum, cnt, mine, sp = 0u;
    for (;;) {
        sum = 0u; cnt = 0u; mine = 0u;
#pragma unroll
        for (unsigned j = 0; j < 16; ++j) { const unsigned c = xb_ld(&bar[XB_XCNT(j)]); sum += c; cnt += (c > 0u) ? 1u : 0u; mine = (j == x) ? c : mine; }
        if (sum == G) break;
        __builtin_amdgcn_s_sleep(1);
        if ((++sp & 255u) == 0u) { if (xb_ld(&bar[XB_TMO])) break; if (sp > XB_SPIN_CAP) { atomicAdd(&bar[XB_TMO], 1u); break; } }
    }
    nloc = mine > 0u ? mine : 1u; nx = cnt > 0u ? cnt : 1u;
}

__device__ __forceinline__ void xcd_barrier(const XcdBarrier& b) {
    asm volatile("s_waitcnt vmcnt(0)" ::: "memory");
    __syncthreads();
    if (threadIdx.x == 0) {
        unsigned* bar = b.bar;
        __builtin_amdgcn_s_waitcnt(0);
        unsigned nloc = b.st[0], nx = b.st[1];
        if (nloc == 0u) { xcd_barrier_complete(bar, b.x, nloc, nx); b.st[0] = nloc; b.st[1] = nx; }
        const unsigned old = xb_add(&bar[XB_XSUB(b.x)], 1u);
        const unsigned gen = old / nloc;
        if (old + 1u == (gen + 1u) * nloc) {
            __builtin_amdgcn_fence(__ATOMIC_RELEASE, "agent");
            asm volatile("s_waitcnt vmcnt(0)" ::: "memory");
            const unsigned og = xb_add(&bar[XB_TOP], 1u);
            const unsigned tg = og / nx;
            if (og + 1u == (tg + 1u) * nx) xb_add(&bar[XB_TOPGEN], 1u);
            else XB_SPIN(xb_ld(&bar[XB_TOPGEN]) == tg, bar);
            __builtin_amdgcn_fence(__ATOMIC_ACQUIRE, "agent");
            xb_add(&bar[XB_XGEN(b.x)], 1u);
            asm volatile("s_waitcnt vmcnt(0)" ::: "memory");
        } else {
            XB_SPIN(xb_ld(&bar[XB_XGEN(b.x)]) == gen, bar);
            __builtin_amdgcn_fence(__ATOMIC_ACQUIRE, "agent");
            asm volatile("s_waitcnt vmcnt(0)" ::: "memory");
        }
    }
    __syncthreads();
}

struct Frame {
    LAS unsigned char* lds;
    volatile LAS unsigned* MISC;
    gu32* ctl;
    int tid, lane, wave;
    int vcu, G;
};
__device__ __forceinline__ float wave_sum(float v) {
#pragma unroll
    for (int o = 1; o < 64; o <<= 1) v += __shfl_xor(v, o);
    return v;
}

__device__ __forceinline__ void refresh(Frame& F) { int t = threadIdx.x; asm volatile("" : "+v"(t)); F.tid = t; F.lane = t & 63; F.wave = __builtin_amdgcn_readfirstlane(t >> 6); }
__device__ __forceinline__ void p0_transpose_item(const float* W, int ldw, int col0, int K, bf16* WT, int drow, const float* gain, LAS float* scr, int kb, int nb, int lane) {
    const int k0 = 64 * kb, n0 = 32 * nb;
    { float v[32]; const float* wp = W + (size_t)(k0 + (lane >> 5)) * ldw + col0 + n0 + (lane & 31);
#pragma unroll
      for (int i = 0; i < 32; ++i) v[i] = wp[(size_t)(2 * i) * ldw];
      if (gain) {
#pragma unroll
          for (int i = 0; i < 32; ++i) v[i] *= gain[k0 + 2 * i + (lane >> 5)]; }
#pragma unroll
      for (int i = 0; i < 32; ++i) scr[(2 * i + (lane >> 5)) * 33 + (lane & 31)] = v[i]; }
    LDS_WAIT(); asm volatile("" ::: "memory");
    const int c = lane & 7;
#pragma unroll
    for (int j = 0; j < 4; ++j) { const int n = (lane >> 3) + 8 * j; const LAS float* s = scr + (8 * c) * 33 + n;
        v4u o; o.x = pk2(s[0 * 33], s[1 * 33]); o.y = pk2(s[2 * 33], s[3 * 33]); o.z = pk2(s[4 * 33], s[5 * 33]); o.w = pk2(s[6 * 33], s[7 * 33]);
        *(GAS v4u*)(WT + (size_t)(drow + n) * K + k0 + 8 * c) = o; }
    LDS_WAIT(); asm volatile("" ::: "memory");
}
__device__ __forceinline__ int pair_row(int n, int half) { return 256 * (n >> 7) + 128 * half + (n & 127); }

struct In { const float *x, *conv_w_in, *conv_k, *conv_w_out, *four_w_out, *mix_g, *ffn_g, *w_gate, *w_up, *w_down, *final_g; };

__device__ __forceinline__ void convert_layer(Frame& F, const In& I, unsigned char* ws, int layer, int widx, int nw) {
    LAS float* scr = (LAS float*)(F.lds + RING_OFF + F.wave * 16384);
    bf16* Win = (bf16*)(ws + WS_WIN); bf16* Wco = (bf16*)(ws + WS_WCO); bf16* Wfo = (bf16*)(ws + WS_WFO); bf16* Wgu = (bf16*)(ws + WS_WGU); bf16* Wd = (bf16*)(ws + WS_WD);
    constexpr int I_CIN = 16 * 32, I_SQ = 16 * 32, I_GU = 16 * 88, I_DN = 44 * 32;
    const int j = layer >> 1, nmix = (layer & 1) ? I_SQ : 3 * I_CIN + I_SQ;
    for (int it = widx; it < nmix + 2 * I_GU + I_DN; it += nw) {
        int r = it;
        if (r < nmix) {
            if (layer & 1) { const int kb = r >> 5, nb = r & 31;
                p0_transpose_item(I.four_w_out + (size_t)j * 1024 * 1024, 1024, 0, 1024, Wfo + (size_t)j * 1024 * 1024, 32 * nb, nullptr, scr, kb, nb, F.lane); continue; }
            if (r < 3 * I_CIN) { const int part = r / I_CIN, idx = r % I_CIN, kb = idx >> 5, nb = idx & 31;
                const int col0 = part == 0 ? 1024 : (part == 1 ? 2048 : 0);
                const int blk = nb >> 2, tile = (blk >> 1) + 4 * (blk & 1);
                const int drow = part == 2 ? 2048 + 32 * nb : 256 * tile + 128 * part + ((32 * nb) & 127);
                p0_transpose_item(I.conv_w_in + (size_t)j * 1024 * 3072, 3072, col0, 1024, Win + (size_t)j * 3072 * 1024, drow, I.mix_g + layer * 1024, scr, kb, nb, F.lane); continue; }
            { const int idx = r - 3 * I_CIN, kb = idx >> 5, nb = idx & 31;
              p0_transpose_item(I.conv_w_out + (size_t)j * 1024 * 1024, 1024, 0, 1024, Wco + (size_t)j * 1024 * 1024, 32 * nb, nullptr, scr, kb, nb, F.lane); continue; }
        }
        r -= nmix;
        if (r < 2 * I_GU) { const int half = r / I_GU, idx = r % I_GU, kb = idx / 88, nb = idx % 88;
            p0_transpose_item((half ? I.w_up : I.w_gate) + (size_t)layer * 1024 * FF, FF, 0, 1024, Wgu + (size_t)layer * 2 * FF * 1024, pair_row(32 * nb, half), I.ffn_g + layer * 1024, scr, kb, nb, F.lane); }
        else { const int idx = r - 2 * I_GU, kb = idx >> 5, nb = idx & 31;
            p0_transpose_item(I.w_down + (size_t)layer * FF * 1024, 1024, 0, FF, Wd + (size_t)layer * 1024 * FF, 32 * nb, nullptr, scr, kb, nb, F.lane); }
    }
}
__device__ __forceinline__ void p0_prologue(Frame& F, const In& I, unsigned char* ws) {
    refresh(F);
    const int gw = F.vcu * NWAVES + F.wave, NGW = F.G * NWAVES;
    convert_layer(F, I, ws, 0, gw, NGW);
    bf16* HB = (bf16*)(ws + WS_HB); float* ssq = (float*)(ws + WS_SSQ);
    for (int m0 = 8 * gw; m0 < M; m0 += 8 * NGW) {
        float keep = 0.f;
#pragma unroll 4
        for (int j = 0; j < 8; ++j) { const int m = m0 + j;
            const GAS f32x4* xr = (const GAS f32x4*)(I.x + (size_t)m * D) + F.lane; GAS unsigned long long* o8 = (GAS unsigned long long*)(HB + (size_t)m * D) + F.lane; float s = 0.f;
#pragma unroll
            for (int jj = 0; jj < 4; ++jj) { const f32x4 v = xr[64 * jj]; s += (v.x * v.x + v.y * v.y) + (v.z * v.z + v.w * v.w);
                o8[64 * jj] = (unsigned long long)pg8::cvt_pk_bf16(v.x, v.y) | ((unsigned long long)pg8::cvt_pk_bf16(v.z, v.w) << 32); }
            s = wave_sum(s);
            if (F.lane == j) keep = s; }
#pragma unroll
        for (int pp = 0; pp < 2; ++pp) { const int p = 8 * pp + (F.lane >> 3); ssq[(size_t)p * M + m0 + (F.lane & 7)] = (p == 0) ? keep : 0.f; }
    }
    bf16* WC2 = (bf16*)(ws + WS_WC2);
    for (int e = (F.vcu * NWAVES * 64 + F.tid) * 2; e < 2 * 1024 * 256; e += F.G * NWAVES * 64 * 2) {
        const int kl = e & 255, n = (e >> 8) & 1023, jf = e >> 18, k = 256 * (n >> 8) + kl, ccg = n >> 1, g = ccg >> 6, cc = ccg & 63, ri = n & 1;
        unsigned w = 0u;
        if ((k >> 7) == g) { const float* gm = I.mix_g + (2 * jf + 1) * 1024; const int kk = k & 127; float v0, v1;
            if (cc == 0) { v0 = 1.f; v1 = ri ? -1.f : 1.f; }
            else { float s0, c0, s1, c1; sincospif((float)((kk * cc) & 127) * (1.0f / 64.0f), &s0, &c0); sincospif((float)(((kk + 1) * cc) & 127) * (1.0f / 64.0f), &s1, &c1);
                v0 = ri ? -s0 : c0; v1 = ri ? -s1 : c1; }
            w = pk2(v0 * gm[k], v1 * gm[k + 1]); }
        *(GAS unsigned*)(WC2 + e) = w;
    }
}

__device__ __forceinline__ void final_norm_phase(Frame& F, float* out, const bf16* HB, const float* ssq, const float* gf) {
    refresh(F);
    const int gw = F.vcu * NWAVES + F.wave, NGW = F.G * NWAVES;
    const GAS f32x4* gr = (const GAS f32x4*)gf + F.lane; const f32x4 g0 = gr[0], g1 = gr[64], g2 = gr[128], g3 = gr[192];
    for (int trip = 0; trip < 2; ++trip) { const int m0 = (NGW == 2048) ? 2048 * (gw >> 8) + 1024 * trip + 4 * (gw & 255) : 4 * gw + 4 * NGW * trip; if (m0 >= M) break;
        float sp[4]; v2u hw[4][4];
#pragma unroll
        for (int j = 0; j < 4; ++j) { const int m = m0 + j; sp[j] = F.lane < 16 ? pg8::ld_agent(ssq + (size_t)F.lane * M + m) : 0.f;
            const GAS v2u* hr = (const GAS v2u*)(HB + (size_t)m * D) + F.lane;
#pragma unroll
            for (int jj = 0; jj < 4; ++jj) hw[j][jj] = hr[64 * jj]; }
#pragma unroll
        for (int j = 0; j < 4; ++j) { const float r = __builtin_amdgcn_rsqf(wave_sum(sp[j]) * (1.0f / 1024.0f) + pg8::RMS_EPS);
            GAS f32x4* xr = (GAS f32x4*)(out + (size_t)(m0 + j) * D) + F.lane;
            xr[0]   = (f32x4){bflo(hw[j][0].x), bfhi(hw[j][0].x), bflo(hw[j][0].y), bfhi(hw[j][0].y)} * r * g0;
            xr[64]  = (f32x4){bflo(hw[j][1].x), bfhi(hw[j][1].x), bflo(hw[j][1].y), bfhi(hw[j][1].y)} * r * g1;
            xr[128] = (f32x4){bflo(hw[j][2].x), bfhi(hw[j][2].x), bflo(hw[j][2].y), bfhi(hw[j][2].y)} * r * g2;
            xr[192] = (f32x4){bflo(hw[j][3].x), bfhi(hw[j][3].x), bflo(hw[j][3].y), bfhi(hw[j][3].y)} * r * g3; }
    }
}

constexpr float C32[32] = {1.000000000e+00f, 9.807852804e-01f, 9.238795325e-01f, 8.314696123e-01f, 7.071067812e-01f, 5.555702330e-01f, 3.826834324e-01f, 1.950903220e-01f, 6.123233996e-17f, -1.950903220e-01f, -3.826834324e-01f, -5.555702330e-01f, -7.071067812e-01f, -8.314696123e-01f, -9.238795325e-01f, -9.807852804e-01f, -1.000000000e+00f, -9.807852804e-01f, -9.238795325e-01f, -8.314696123e-01f, -7.071067812e-01f, -5.555702330e-01f, -3.826834324e-01f, -1.950903220e-01f, -1.836970199e-16f, 1.950903220e-01f, 3.826834324e-01f, 5.555702330e-01f, 7.071067812e-01f, 8.314696123e-01f, 9.238795325e-01f, 9.807852804e-01f};
constexpr int BR4[16] = {0, 8, 4, 12, 2, 10, 6, 14, 1, 9, 5, 13, 3, 11, 7, 15};
constexpr int BR5[32] = {0, 16, 8, 24, 4, 20, 12, 28, 2, 18, 10, 26, 6, 22, 14, 30, 1, 17, 9, 25, 5, 21, 13, 29, 3, 19, 11, 27, 7, 23, 15, 31};
template <int N, int LOGN> __device__ __forceinline__ void fft_dif(float (&re)[N], float (&im)[N]) {
#pragma unroll
    for (int st = 0; st < LOGN; ++st) { const int len = N >> st, half = len >> 1, step = 32 / len;
#pragma unroll
        for (int base = 0; base < N; base += len)
#pragma unroll
            for (int j = 0; j < half; ++j) { const int a = base + j, b = a + half;
                const float ar = re[a], ai = im[a], br = re[b], bi = im[b]; re[a] = ar + br; im[a] = ai + bi;
                const float dr = ar - br, di = ai - bi; const int m = (j * step) & 31;
                if (m == 0) { re[b] = dr; im[b] = di; }
                else if (m == 8) { re[b] = di; im[b] = -dr; }
                else { const float wr = C32[m], ws = C32[(m + 24) & 31]; re[b] = dr * wr + di * ws; im[b] = di * wr - dr * ws; }
                asm("" : "+v"(re[a])); asm("" : "+v"(im[a])); asm("" : "+v"(re[b])); asm("" : "+v"(im[b])); } }
}
typedef float f32x2v __attribute__((ext_vector_type(2)));
template <int N, int LOGN> __device__ __forceinline__ void fft_dif2(f32x2v (&re)[N], f32x2v (&im)[N]) {
#pragma unroll
    for (int st = 0; st < LOGN; ++st) { const int len = N >> st, half = len >> 1, step = 32 / len;
#pragma unroll
        for (int base = 0; base < N; base += len)
#pragma unroll
            for (int j = 0; j < half; ++j) { const int a = base + j, b = a + half;
                const f32x2v ar = re[a], ai = im[a], br = re[b], bi = im[b]; re[a] = ar + br; im[a] = ai + bi;
                const f32x2v dr = ar - br, di = ai - bi; const int m = (j * step) & 31;
                if (m == 0) { re[b] = dr; im[b] = di; }
                else if (m == 8) { re[b] = di; im[b] = -dr; }
                else { const float wr = C32[m], ws = C32[(m + 24) & 31]; re[b] = dr * wr + di * ws; im[b] = di * wr - dr * ws; }
                asm("" : "+v"(re[a])); asm("" : "+v"(im[a])); asm("" : "+v"(re[b])); asm("" : "+v"(im[b])); } }
}
__device__ __forceinline__ int fft_off(int r) { return 16 * (r + (r >> 5)); }
template <int SB> __device__ __forceinline__ void pass16(LAS unsigned char* base, float wr, float wi) {
    f32x2v re[16], im[16];
#pragma unroll
    for (int q = 0; q < 16; ++q) { const v2u w = *(const LAS v2u*)(base + SB * q); re[q] = (f32x2v){bflo(w.x), bflo(w.y)}; im[q] = (f32x2v){bfhi(w.x), bfhi(w.y)}; }
    fft_dif2<16, 4>(re, im);
    float pr = 1.f, pi = 0.f;
#pragma unroll
    for (int k = 0; k < 16; ++k) { const f32x2v xr = re[BR4[k]], xi = im[BR4[k]], orr = xr * pr - xi * pi, oi = xr * pi + xi * pr;
        v2u o; o.x = pg8::cvt_pk_bf16(orr.x, oi.x); o.y = pg8::cvt_pk_bf16(orr.y, oi.y);
        *(LAS v2u*)(base + SB * k) = o;
        const float npr = pr * wr - pi * wi; pi = pr * wi + pi * wr; pr = npr; }
}
struct __attribute__((packed, aligned(2))) P8u { unsigned a, b; };
__device__ __forceinline__ int fft_slot(int k) { const int r = 512 * (k & 15) + 32 * ((k >> 4) & 15) + (k >> 8); return 16 * (r + (r >> 5) + (r >> 9)); }
__device__ __forceinline__ void fft_phase(Frame& F, const bf16* Yc, bf16* Y) {
    refresh(F);
    LAS unsigned char* buf = F.lds + RING_OFF; const int t = F.tid;
    for (int item = F.vcu; item < 256; item += F.G) {
        const int b = item >> 7, g = (item >> 4) & 7, q4 = item & 15;
        const bf16* src = Yc + ((size_t)b * SEQ + t) * 1024 + 128 * g + 8 * q4;
        LAS unsigned char* lt = buf + 16 * (t + (t >> 5));
#pragma unroll 1
        for (int i = 0; i < 16; i += 8) { v4u v[8];
#pragma unroll
            for (int j = 0; j < 8; ++j) v[j] = *(const GAS v4u*)(src + (size_t)(512 * (i + j)) * 1024);
#pragma unroll
            for (int j = 0; j < 8; ++j) *(LAS v4u*)(lt + 8464 * (i + j)) = v[j]; }
        __syncthreads();
        { float sn, cs; sincospif((float)t * (1.0f / 4096.0f), &sn, &cs);
#pragma unroll 1
          for (int cp = 0; cp < 2; ++cp) pass16<8464>(lt + 8 * cp, cs, -sn); }
        __syncthreads();
        { const int ka = t >> 5, sc = t & 31; float sn, cs; sincospif((float)sc * (1.0f / 256.0f), &sn, &cs);
          LAS unsigned char* l2 = buf + 16 * (529 * ka + sc);
#pragma unroll 1
          for (int cp = 0; cp < 2; ++cp) pass16<528>(l2 + 8 * cp, cs, -sn); }
        __syncthreads();
        { const int col = t >> 1; LAS unsigned char* l3 = buf + 16 * (529 * (col >> 4) + 33 * (col & 15)) + 8 * (t & 1);
#pragma unroll 1
          for (int c = 0; c < 2; ++c) { float re[32], im[32];
#pragma unroll
              for (int qq = 0; qq < 32; ++qq) { const unsigned w = *(const LAS unsigned*)(l3 + 4 * c + 16 * qq); re[qq] = bflo(w); im[qq] = bfhi(w); }
              fft_dif<32, 5>(re, im);
#pragma unroll
              for (int k = 0; k < 32; ++k) *(LAS unsigned*)(l3 + 4 * c + 16 * k) = pg8::cvt_pk_bf16(re[BR5[k]], im[BR5[k]]); } }
        __syncthreads();
        bf16* dst = Y + ((size_t)b * SEQ) * 1024 + 128 * g;
        const float sc1 = 1.0f / 1024.0f;
#pragma unroll 2
        for (int i = 0; i < 16; ++i) { const int k = t + 512 * i, km = (SEQ - k) & (SEQ - 1);
            const v4u v = *(const LAS v4u*)(buf + fft_slot(k)), w = *(const LAS v4u*)(buf + fft_slot(km));
            float d0 = bflo(v.x) * sc1, m0 = bflo(w.x) * sc1;
            if (q4 == 0) { d0 = 0.5f * sc1 * (bflo(v.x) + bflo(w.x)); m0 = 0.5f * sc1 * (bfhi(v.x) + bfhi(w.x)); }
            bf16* row = dst + (size_t)k * 1024;
            v2u o; o.x = pg8::cvt_pk_bf16(d0, bflo(v.y) * sc1); o.y = pg8::cvt_pk_bf16(bflo(v.z) * sc1, bflo(v.w) * sc1);
            *(GAS v2u*)(row + 4 * q4) = o;
            const unsigned m12 = pg8::cvt_pk_bf16(bflo(w.z) * sc1, bflo(w.y) * sc1);
            const unsigned m3 = pg8::cvt_pk_bf16(bflo(w.w) * sc1, 0.f) & 0xffffu, mz = pg8::cvt_pk_bf16(m0, 0.f) & 0xffffu;
            if (q4 != 0) { P8u o2; o2.a = m3 | (m12 << 16); o2.b = (m12 >> 16) | (mz << 16); *(P8u*)(row + 125 - 4 * q4) = o2; }
            else { row[125] = (bf16)m3; *(GAS unsigned*)(row + 126) = m12; row[64] = (bf16)mz; }
        }
        __syncthreads();
    }
}
__device__ __forceinline__ void conv_halo_fix(int pm, const bf16* U, const bf16* HZ, const bf16* HBg, const float* taps, bf16* Z) {
    int t_l = threadIdx.x; asm volatile("" : "+v"(t_l));
    const int t = t_l, side = t >> 8, c4 = (t & 255) * 4, row = side ? 256 * pm + 255 : 256 * pm, sq = row & (SEQ - 1);
    if (side ? (sq != SEQ - 1) : (sq != 0)) {
        const size_t ho = (size_t)(2 * pm + side) * 1024 + c4; const int nrow = side ? row + 1 : row - 1;
        const v2u zp = *(const GAS v2u*)(HZ + ho), b = *(const GAS v2u*)(HBg + ho), un = *(const GAS v2u*)(U + (size_t)nrow * 1024 + c4); const f32x4 k = *(const GAS f32x4*)(taps + (side ? 2048 : 0) + c4);
        v2u o; o.x = pg8::cvt_pk_bf16(bflo(zp.x) + bflo(b.x) * k[0] * bflo(un.x), bfhi(zp.x) + bfhi(b.x) * k[1] * bfhi(un.x));
        o.y = pg8::cvt_pk_bf16(bflo(zp.y) + bflo(b.y) * k[2] * bflo(un.y), bfhi(zp.y) + bfhi(b.y) * k[3] * bfhi(un.y));
        *(GAS v2u*)(Z + (size_t)row * 1024 + c4) = o;
    }
    asm volatile("s_waitcnt vmcnt(0)" ::: "memory");
    __syncthreads();
}
struct Args { const float* in[11]; float* out; unsigned char* ws; int ph_lo, ph_hi; };
__global__ void __launch_bounds__(NWAVES * 64, 2) mk_fwd(Args args) {
    extern __shared__ __attribute__((aligned(16))) unsigned char lds[];
    Frame F;
    F.lds = (LAS unsigned char*)lds;
    F.MISC = (volatile LAS unsigned*)(F.lds + MISC_OFF);
    F.tid = threadIdx.x; F.lane = F.tid & 63; F.wave = __builtin_amdgcn_readfirstlane(F.tid >> 6);
    F.G = gridDim.x; { const int bx = blockIdx.x; F.vcu = (F.G % 8 == 0) ? (bx % 8) * (F.G / 8) + bx / 8 : bx; }
    unsigned char* ws = args.ws;
    F.ctl = (gu32*)(ws + WS_CTL);
    In I; I.x = args.in[0]; I.conv_w_in = args.in[1]; I.conv_k = args.in[2]; I.conv_w_out = args.in[3]; I.four_w_out = args.in[4]; I.mix_g = args.in[5]; I.ffn_g = args.in[6];
    I.w_gate = args.in[7]; I.w_up = args.in[8]; I.w_down = args.in[9]; I.final_g = args.in[10];
    for (int u = F.tid; u < (LDS_BYTES - LDSCTL_OFF) / 4; u += NWAVES * 64) ((LAS unsigned*)(F.lds + LDSCTL_OFF))[u] = 0u;
    __syncthreads();
    XcdBarrier bar; bar.bar = (unsigned*)(F.ctl + CW_BAR); bar.x = 0; bar.st = nullptr;
    if (!MK_PER_PHASE) bar = xcd_barrier_post((unsigned*)(F.ctl + CW_BAR), F.MISC + 8);
    const int lo = args.ph_lo, hi = args.ph_hi;
#define IN(k) (lo <= (k) && (k) < hi)
#define SEAM(k) do { if (!MK_PER_PHASE && IN(k) && IN((k) + 1)) xcd_barrier(bar); } while (0)
    float* const hout = args.out;
    bf16* const HB = (bf16*)(ws + WS_HB); bf16* const ZY = (bf16*)(ws + WS_ZY); bf16* const ACT = (bf16*)(ws + WS_ACT);
    bf16* const UU = ACT + (size_t)M * 1024;
    float* const ssq = (float*)(ws + WS_SSQ);

    if (IN(0)) p0_prologue(F, I, ws);
    SEAM(0);
#pragma unroll 1
    for (int i = 0; i < DEPTH; ++i) {
        const int p = 1 + 6 * i, j = i >> 1;
        bf16* const HALO = (bf16*)(ws + WS_HALO);
        bf16* const YC = ACT;
        if ((i & 1) == 0) {
            if (IN(p)) { pg8::Gemm g{HB, (const bf16*)(ws + WS_WIN) + (size_t)j * 3072 * 1024, M, 3072, D}; pg8::StaticOrder S; S.init(M, 3072, F.G, (int)blockIdx.x);
                pg8::EpiConvFused E{UU, ZY, HALO, HALO + 128 * 1024, ssq, I.conv_k + (size_t)j * 3 * 1024};
                pg8::gemm_phase<pg8::EpiConvFused, pg8::StaticOrder, true, true>(F.lds + RING_OFF, g, S, E); }
            if (!MK_PER_PHASE && IN(p) && IN(p + 3)) xcd_barrier(bar);
        } else {
            if (IN(p)) { pg8::Gemm g{HB, (const bf16*)(ws + WS_WC2) + (size_t)j * 1024 * 256, M, 1024, 256};     pg8::StaticOrder S; S.init(M, 1024, F.G, (int)blockIdx.x);
                pg8::EpiScale E{YC, 1024, ssq};
                pg8::gemm_phase<pg8::EpiScale, pg8::StaticOrder, true, true, 1024, 256>(F.lds + RING_OFF, g, S, E); }
            SEAM(p);
            if (IN(p + 1)) fft_phase(F, YC, ZY);
            if (!MK_PER_PHASE && IN(p + 1) && IN(p + 3)) xcd_barrier(bar);
        }
        if (IN(p + 3)) { const bf16* Wt = (i & 1) ? (const bf16*)(ws + WS_WFO) + (size_t)j * 1024 * 1024 : (const bf16*)(ws + WS_WCO) + (size_t)j * 1024 * 1024;
            pg8::Gemm g{ZY, Wt, M, D, D}; pg8::StaticOrder S; S.init(M, D, F.G, (int)blockIdx.x);
            if ((i & 1) == 0) { pg8::Unit uu; for (int k = 0; S.next(k, uu); ++k) conv_halo_fix(uu.pm, UU, HALO, HALO + 128 * 1024, I.conv_k + (size_t)j * 3 * 1024, ZY); }
            pg8::EpiResid E{HB, ssq};
            pg8::gemm_phase<pg8::EpiResid, pg8::StaticOrder, true, true>(F.lds + RING_OFF, g, S, E); }
        SEAM(p + 3);
        if (IN(p + 4)) { pg8::Gemm g{HB, (const bf16*)(ws + WS_WGU) + (size_t)i * 2 * FF * 1024, M, 2 * FF, D}; pg8::StaticOrder S; S.init(M, 2 * FF, F.G, (int)blockIdx.x);
            pg8::EpiSwiGLU E{ACT, FF, ssq};
            pg8::gemm_phase<pg8::EpiSwiGLU, pg8::StaticOrder, true, true>(F.lds + RING_OFF, g, S, E);
            if (i + 1 < DEPTH) {
                const int nfull = S.nwg % F.G, c = (int)blockIdx.x;
                if (nfull == 0) { refresh(F); convert_layer(F, I, ws, i + 1, c * NWAVES + F.wave, F.G * NWAVES); }
                else if (c >= nfull) { refresh(F); convert_layer(F, I, ws, i + 1, (c - nfull) * NWAVES + F.wave, (F.G - nfull) * NWAVES); } } }
        SEAM(p + 4);
        if (IN(p + 5)) { pg8::Gemm g{ACT, (const bf16*)(ws + WS_WD) + (size_t)i * 1024 * FF, M, D, FF}; pg8::StaticOrder S; S.init(M, D, F.G, (int)blockIdx.x);
            pg8::EpiResid E{HB, ssq};
            pg8::gemm_phase<pg8::EpiResid, pg8::StaticOrder, true, true>(F.lds + RING_OFF, g, S, E); }
        SEAM(p + 5);
    }
    if (IN(N_PHASES - 1)) final_norm_phase(F, hout, HB, ssq, I.final_g);
#undef IN
#undef SEAM
}

extern "C" void kernel_launch(void* const* d_in, const int* in_sizes, int n_in, void* d_out, int out_size, void* d_ws, size_t ws_size, hipStream_t stream) {
    static int grid = 0;
    if (grid == 0) {
        if (n_in != 11 || in_sizes[0] != M * D || out_size != M * D || ws_size < WS_END) { fprintf(stderr, "kernel_launch: unexpected shapes (n_in %d, in0 %d, out %d, ws %zu); nothing launched\n", n_in, n_in > 0 ? in_sizes[0] : -1, out_size, ws_size); grid = -1; return; }
        int dev = 0, cus = 0, per_cu = 0;
        if (hipGetDevice(&dev) != hipSuccess || hipDeviceGetAttribute(&cus, hipDeviceAttributeMultiprocessorCount, dev) != hipSuccess) { fprintf(stderr, "kernel_launch: device query failed\n"); grid = -1; return; }
        if (hipFuncSetAttribute((const void*)mk_fwd, hipFuncAttributeMaxDynamicSharedMemorySize, LDS_BYTES) != hipSuccess) { fprintf(stderr, "kernel_launch: hipFuncSetAttribute failed\n"); grid = -1; return; }
        if (hipOccupancyMaxActiveBlocksPerMultiprocessor(&per_cu, (const void*)mk_fwd, NWAVES * 64, LDS_BYTES) != hipSuccess || per_cu < 1)
            fprintf(stderr, "kernel_launch: note: occupancy query reports %d workgroups per CU\n", per_cu);
        (void)hipGetLastError();
        grid = cus;
        if (grid != 256) { fprintf(stderr, "kernel_launch: this kernel's fused conv mixer needs exactly 256 workgroups (one per CU of a 256-CU device); found %d CUs; nothing launched\n", cus); grid = -1; return; }
    }
    if (grid < 0) return;
    if (hipMemsetAsync((char*)d_ws + WS_CTL, 0, CTL_ZERO_BYTES, stream) != hipSuccess) { fprintf(stderr, "kernel_launch: hipMemsetAsync failed\n"); return; }
    Args a{};
    for (int i = 0; i < 11; ++i) a.in[i] = (const float*)d_in[i];
    a.out = (float*)d_out; a.ws = (unsigned char*)d_ws;
#if MK_PER_PHASE
    for (int ph = 0; ph < N_PHASES; ++ph) { a.ph_lo = ph; a.ph_hi = ph + 1;
        hipLaunchKernelGGL(mk_fwd, dim3(grid), dim3(NWAVES * 64), LDS_BYTES, stream, a); }
#else
    a.ph_lo = 0; a.ph_hi = N_PHASES;
    hipLaunchKernelGGL(mk_fwd, dim3(grid), dim3(NWAVES * 64), LDS_BYTES, stream, a);
#endif
    const hipError_t le = hipPeekAtLastError();
    if (le != hipSuccess) fprintf(stderr, "kernel_launch: launch failed: %s\n", hipGetErrorName(le));
}
```

```cpp
#include <hip/hip_runtime.h>
#include <cstdio>
#include <cstdint>
#ifndef MK_PER_PHASE
#define MK_PER_PHASE 0
#endif
namespace pg8 {
#define PG8_LAS __attribute__((address_space(3)))
typedef unsigned short bf16_t;
typedef short bf16x8 __attribute__((ext_vector_type(8)));
typedef float f32x4 __attribute__((ext_vector_type(4)));
typedef unsigned u32x4 __attribute__((ext_vector_type(4)));
constexpr int BM = 256, BK = 64, HALF = 128, HTB = HALF * BK * 2  , STAGE_BYTES = 8 * HTB, NXCD = 8, WGM = 8;

__host__ __device__ __forceinline__ int lds_byte(int r, int c) { const int st = (r >> 4) * 2 + (c >> 5), rr = r & 15, cc = c & 31, ob = rr * 64 + cc * 2; return st * 1024 + (ob ^ (((ob >> 9) & 1) << 5)); }
__host__ __device__ __forceinline__ void stage_rc(int b, int& R, int& C) { const int st = b / 1024, sb = b % 1024, swz = sb ^ (((sb >> 9) & 1) << 5); R = (st >> 1) * 16 + swz / 64; C = (st & 1) * 32 + (swz % 64) / 2; }
__host__ __device__ __forceinline__ int perm32(int rho) { const int n = rho >> 4, i = rho & 15; return 8 * (i >> 2) + 4 * n + (i & 3); }

struct Unit { int pm, pn; };
struct Gemm { const bf16_t* A; const bf16_t* Bt; int M, N, K; };

struct StaticOrder {
    int nM, nN, nwg, G, c;
    __host__ __device__ void init(int M, int N, int G_, int c_) { nM = M / BM; nN = N / BM; nwg = nM * nN; G = G_; c = c_; }
    __host__ __device__ bool next(int i, Unit& u) const {
        const long L = (long)i * G + c; if (L >= nwg) return false;
        int wgid = (int)L; { const int q = nwg / NXCD, r = nwg % NXCD, xcd = wgid % NXCD, off = wgid / NXCD; wgid = (xcd < r ? xcd * (q + 1) : r * (q + 1) + (xcd - r) * q) + off; }
        const int nig = WGM * nN, gid = wgid / nig, fm = gid * WGM, gsz = (nM - fm) < WGM ? (nM - fm) : WGM;
        u.pm = fm + ((wgid % nig) % gsz); u.pn = (wgid % nig) / gsz; return true;
    }
    __device__ __forceinline__ void a_ready(const Unit&) const {}
    __device__ __forceinline__ void done(const Unit&) const {}
};


typedef __bf16 bf16x2_t __attribute__((ext_vector_type(2)));
typedef float f32x2_t __attribute__((ext_vector_type(2)));
__device__ __forceinline__ unsigned cvt_pk_bf16(float lo, float hi) { f32x2_t v = {lo, hi}; bf16x2_t b = __builtin_convertvector(v, bf16x2_t); return __builtin_bit_cast(unsigned, b); }
constexpr float RMS_EPS = 1e-5f;
__device__ __forceinline__ float ld_agent(const float* p) { return *p; }
__device__ __forceinline__ float row_rs(const float* ssq, int row, int fq) {
    const float* p = ssq + (size_t)(4 * fq) * 16384 + row;
    float s = (ld_agent(p) + ld_agent(p + 16384)) + (ld_agent(p + 2 * 16384) + ld_agent(p + 3 * 16384));
    s += __shfl_xor(s, 16); s += __shfl_xor(s, 32);
    return __builtin_amdgcn_rsqf(s * (1.0f / 1024.0f) + RMS_EPS);
}
__device__ __forceinline__ void row_rs8(const float* ssq, int row0, int fq, float (&rr)[2][4]) {
    float v[2][4][4];
#pragma unroll
    for (int ai = 0; ai < 2; ++ai)
#pragma unroll
        for (int m = 0; m < 4; ++m) { const float* p = ssq + (size_t)(4 * fq) * 16384 + row0 + ai * HALF + m * 16;
#pragma unroll
            for (int k = 0; k < 4; ++k) v[ai][m][k] = ld_agent(p + k * 16384); }
#pragma unroll
    for (int ai = 0; ai < 2; ++ai)
#pragma unroll
        for (int m = 0; m < 4; ++m) { float s = (v[ai][m][0] + v[ai][m][1]) + (v[ai][m][2] + v[ai][m][3]);
            s += __shfl_xor(s, 16); s += __shfl_xor(s, 32); rr[ai][m] = __builtin_amdgcn_rsqf(s * (1.0f / 1024.0f) + RMS_EPS); }
}
__device__ __forceinline__ float bf_lo(unsigned w) { return __builtin_bit_cast(float, w << 16); }
__device__ __forceinline__ float bf_hi(unsigned w) { return __builtin_bit_cast(float, w & 0xffff0000u); }
struct EpiConvFused {
    static constexpr bool PERM = true, AFTER_DRAIN = false, ROWSCALE = false;
    bf16_t* U; bf16_t* Z; bf16_t* HZ; bf16_t* HBg; const float* ssq; const float* taps;
    __device__ __forceinline__ void operator()(const f32x4 (&acc)[2][2][4][2], const Unit& u, int wr, int wc, int fr, int fq) const {
        const int row0 = u.pm * BM + wr * 64 + fr; float rr[2][4]; row_rs8(ssq, row0, fq, rr);
        if (u.pn < 8) {
            const int col0 = (2 * (u.pn & 3) + (u.pn >> 2)) * 128 + wc * 32 + 8 * fq;
#pragma unroll
            for (int ai = 0; ai < 2; ++ai)
#pragma unroll
                for (int m = 0; m < 4; ++m) { const int row = row0 + ai * HALF + m * 16; const float r = rr[ai][m], r2 = r * r;
                    const f32x4 v0 = acc[ai][0][m][0] * acc[ai][1][m][0] * r2, v1 = acc[ai][0][m][1] * acc[ai][1][m][1] * r2;
                    u32x4 w; w.x = cvt_pk_bf16(v0[0], v0[1]); w.y = cvt_pk_bf16(v0[2], v0[3]); w.z = cvt_pk_bf16(v1[0], v1[1]); w.w = cvt_pk_bf16(v1[2], v1[3]);
                    *(u32x4*)(U + (size_t)row * 1024 + col0) = w; }
            asm volatile("s_waitcnt vmcnt(0)" ::: "memory");
        } else {
            asm volatile("s_waitcnt vmcnt(0)" ::: "memory");
#pragma unroll
            for (int bj = 0; bj < 2; ++bj) {
                const int col = (u.pn - 8) * BM + bj * HALF + wc * 32 + 8 * fq;
                const f32x4 k0a = *(const f32x4*)(taps + col), k0b = *(const f32x4*)(taps + col + 4), k1a = *(const f32x4*)(taps + 1024 + col), k1b = *(const f32x4*)(taps + 1024 + col + 4),
                            k2a = *(const f32x4*)(taps + 2048 + col), k2b = *(const f32x4*)(taps + 2048 + col + 4);
#pragma unroll
                for (int ai = 0; ai < 2; ++ai)
#pragma unroll
                    for (int m = 0; m < 4; ++m) { const int row = row0 + ai * HALF + m * 16, sq = row & 8191, lr = row & 255; const float r = rr[ai][m];
                        const bool up_in = lr != 0, dn_in = lr != 255, up_halo = !up_in && sq != 0, dn_halo = !dn_in && sq != 8191;
                        const bf16_t* up = U + (size_t)row * 1024 + col; const u32x4 z0 = {0u, 0u, 0u, 0u};
                        const u32x4 uc = *(const u32x4*)up, ul = up_in ? *(const u32x4*)(up - 1024) : z0, ur = dn_in ? *(const u32x4*)(up + 1024) : z0;
                        const f32x4 b0 = acc[ai][bj][m][0] * r, b1 = acc[ai][bj][m][1] * r;
                        u32x4 w;
                        w.x = cvt_pk_bf16(b0[0] * (k0a[0] * bf_lo(ul.x) + k1a[0] * bf_lo(uc.x) + k2a[0] * bf_lo(ur.x)), b0[1] * (k0a[1] * bf_hi(ul.x) + k1a[1] * bf_hi(uc.x) + k2a[1] * bf_hi(ur.x)));
                        w.y = cvt_pk_bf16(b0[2] * (k0a[2] * bf_lo(ul.y) + k1a[2] * bf_lo(uc.y) + k2a[2] * bf_lo(ur.y)), b0[3] * (k0a[3] * bf_hi(ul.y) + k1a[3] * bf_hi(uc.y) + k2a[3] * bf_hi(ur.y)));
                        w.z = cvt_pk_bf16(b1[0] * (k0b[0] * bf_lo(ul.z) + k1b[0] * bf_lo(uc.z) + k2b[0] * bf_lo(ur.z)), b1[1] * (k0b[1] * bf_hi(ul.z) + k1b[1] * bf_hi(uc.z) + k2b[1] * bf_hi(ur.z)));
                        w.w = cvt_pk_bf16(b1[2] * (k0b[2] * bf_lo(ul.w) + k1b[2] * bf_lo(uc.w) + k2b[2] * bf_lo(ur.w)), b1[3] * (k0b[3] * bf_hi(ul.w) + k1b[3] * bf_hi(uc.w) + k2b[3] * bf_hi(ur.w)));
                        if (up_halo || dn_halo) { const size_t ho = (size_t)(2 * u.pm + (dn_halo ? 1 : 0)) * 1024 + col;
                            u32x4 bw; bw.x = cvt_pk_bf16(b0[0], b0[1]); bw.y = cvt_pk_bf16(b0[2], b0[3]); bw.z = cvt_pk_bf16(b1[0], b1[1]); bw.w = cvt_pk_bf16(b1[2], b1[3]);
                            *(u32x4*)(HZ + ho) = w; *(u32x4*)(HBg + ho) = bw; }
                        else *(u32x4*)(Z + (size_t)row * 1024 + col) = w; }
            }
        }
    }
};
__device__ __forceinline__ float silu_mul(float a, float b) { return a * b * __builtin_amdgcn_rcpf(1.0f + __builtin_amdgcn_exp2f(a * -1.4426950408889634f)); }
struct EpiSwiGLU {
    static constexpr bool PERM = true, AFTER_DRAIN = false, ROWSCALE = true;
    bf16_t* O; int ldc; const float* ssq;
    __device__ __forceinline__ void operator()(const f32x4 (&acc)[2][2][4][2], const Unit& u, int wr, int wc, int fr, int fq, const float (&rr)[2][4]) const {
        const int row0 = u.pm * BM + wr * 64 + fr, col0 = u.pn * 128 + wc * 32 + 8 * fq;
#pragma unroll
        for (int ai = 0; ai < 2; ++ai)
#pragma unroll
            for (int m = 0; m < 4; ++m) { const int row = row0 + ai * HALF + m * 16; const float r = rr[ai][m];
                const f32x4 g0 = acc[ai][0][m][0] * r, g1 = acc[ai][0][m][1] * r, u0 = acc[ai][1][m][0] * r, u1 = acc[ai][1][m][1] * r;
                u32x4 w; w.x = cvt_pk_bf16(silu_mul(g0[0], u0[0]), silu_mul(g0[1], u0[1])); w.y = cvt_pk_bf16(silu_mul(g0[2], u0[2]), silu_mul(g0[3], u0[3]));
                w.z = cvt_pk_bf16(silu_mul(g1[0], u1[0]), silu_mul(g1[1], u1[1])); w.w = cvt_pk_bf16(silu_mul(g1[2], u1[2]), silu_mul(g1[3], u1[3]));
                *(u32x4*)(O + (size_t)row * ldc + col0) = w; }
    }
};
struct EpiScale {
    static constexpr bool PERM = true, AFTER_DRAIN = false, ROWSCALE = false;
    bf16_t* O; int ldc; const float* ssq;
    __device__ __forceinline__ void operator()(const f32x4 (&acc)[2][2][4][2], const Unit& u, int wr, int wc, int fr, int fq) const {
        const int row0 = u.pm * BM + wr * 64 + fr, col0 = u.pn * BM + wc * 32 + 8 * fq; float rr[2][4]; row_rs8(ssq, row0, fq, rr);
#pragma unroll
        for (int ai = 0; ai < 2; ++ai)
#pragma unroll
            for (int m = 0; m < 4; ++m) { const int row = row0 + ai * HALF + m * 16; const float r = rr[ai][m];
#pragma unroll
                for (int bj = 0; bj < 2; ++bj) { const f32x4 v0 = acc[ai][bj][m][0] * r, v1 = acc[ai][bj][m][1] * r;
                    u32x4 w; w.x = cvt_pk_bf16(v0[0], v0[1]); w.y = cvt_pk_bf16(v0[2], v0[3]); w.z = cvt_pk_bf16(v1[0], v1[1]); w.w = cvt_pk_bf16(v1[2], v1[3]);
                    *(u32x4*)(O + ((size_t)((row >> 13) * (ldc >> 3) + ((col0 + bj * HALF) >> 3)) * 8192 + (row & 8191)) * 8) = w; } }
    }
};
struct EpiResid {
    static constexpr bool PERM = false, AFTER_DRAIN = false, ROWSCALE = false;
    bf16_t* hb; float* ssq;
    __device__ __forceinline__ void operator()(const f32x4 (&acc)[2][2][4][2], const Unit& u, int wr, int wc, int fr, int fq) const {
        typedef unsigned u32x2v __attribute__((ext_vector_type(2)));
        const int row0 = u.pm * BM + wr * 64 + fr, col0 = u.pn * BM + wc * 32 + 4 * fq;
        u32x2v bs[2][4][2][2];
#pragma unroll
        for (int ai = 0; ai < 2; ++ai)
#pragma unroll
            for (int m = 0; m < 4; ++m)
#pragma unroll
                for (int bj = 0; bj < 2; ++bj)
#pragma unroll
                    for (int n = 0; n < 2; ++n) bs[ai][m][bj][n] = *(const u32x2v*)(hb + (size_t)(row0 + ai * HALF + m * 16) * 1024 + col0 + bj * HALF + n * 16);
#pragma unroll
        for (int ai = 0; ai < 2; ++ai)
#pragma unroll
            for (int m = 0; m < 4; ++m) { const int row = row0 + ai * HALF + m * 16; const size_t off = (size_t)row * 1024 + col0; float q = 0.f;
#pragma unroll
                for (int bj = 0; bj < 2; ++bj)
#pragma unroll
                    for (int n = 0; n < 2; ++n) { const size_t o2 = off + bj * HALF + n * 16; const u32x2v b = bs[ai][m][bj][n];
                        const f32x4 bf = {__builtin_bit_cast(float, b.x << 16), __builtin_bit_cast(float, b.x & 0xffff0000u), __builtin_bit_cast(float, b.y << 16), __builtin_bit_cast(float, b.y & 0xffff0000u)};
                        const f32x4 o = bf + acc[ai][bj][m][n];
                        u32x2v w; w.x = cvt_pk_bf16(o[0], o[1]); w.y = cvt_pk_bf16(o[2], o[3]); *(u32x2v*)(hb + o2) = w;
                        q += (o[0] * o[0] + o[1] * o[1]) + (o[2] * o[2] + o[3] * o[3]); }
                q += __shfl_xor(q, 16); q += __shfl_xor(q, 32);
                if (fq == 0) ssq[(size_t)(4 * u.pn + wc) * 16384 + row] = q; }
    }
};
template <class Epi, class Sched, bool ALIGN_EPI = false, bool SP2 = false, int LDA = 0, int ACOL = 0>
__device__ __forceinline__ void gemm_phase(PG8_LAS unsigned char* lds, const Gemm g, const Sched& S, const Epi& E) {
    int tid_l = threadIdx.x; asm volatile("" : "+v"(tid_l));
    const int tid = tid_l, wid = __builtin_amdgcn_readfirstlane(tid >> 6), lane = tid & 63, wr = wid >> 2, wc = wid & 3, fr = lane & 15, fq = lane >> 4;
    int K_l = g.K; asm volatile("" : "+s"(K_l));
    const int K = K_l, nt = K / BK;
    const bf16_t* gA = g.A; const bf16_t* gB = g.Bt; asm volatile("" : "+s"(gA), "+s"(gB));
    unsigned voffA[2], voffB[2];
#pragma unroll
    for (int i = 0; i < 2; ++i) { int R, C; stage_rc(tid * 16 + i * 8192, R, C); const int Rb = Epi::PERM ? ((R & ~31) + perm32(R & 31)) : R;
        voffA[i] = (unsigned)(R * (LDA ? LDA : K) + C) * 2u; voffB[i] = (unsigned)(Rb * K + C) * 2u; }
    const size_t kstep = (size_t)(BK * 2);
    const size_t hstepB = (size_t)HALF * K * 2, hstepA = LDA ? (size_t)HALF * LDA * 2 : hstepB;
    const size_t tstepA = 2 * hstepA, tstepB = 2 * hstepB; constexpr size_t acolB = (size_t)ACOL * 2;
    const unsigned ldsw = (unsigned)wid * 1024u;
    const int aoff = lds_byte(wr * 64 + fr, fq * 8), boff = lds_byte(wc * 32 + fr, fq * 8);
#define PG8_SA(b, h) (((b) * 2 + (h)) * HTB)
#define PG8_SB(b, h) ((4 + (b) * 2 + (h)) * HTB)
#define PG8_STAGE(bufoff, gbase, voff) do { _Pragma("unroll") for (int _i = 0; _i < 2; ++_i) \
        __builtin_amdgcn_global_load_lds((const unsigned*)((const char*)(gbase) + (voff)[_i]), (PG8_LAS unsigned*)(lds + (bufoff) + ldsw + _i * 8192), 16, 0, 0); } while (0)
#define PG8_LDA(dst, b, h) do { _Pragma("unroll") for (int m = 0; m < 4; ++m) _Pragma("unroll") for (int k = 0; k < 2; ++k) dst[m][k] = *(const PG8_LAS bf16x8*)(lds + PG8_SA(b, h) + aoff + m * 2048 + k * 1024); } while (0)
#define PG8_LDB(dst, b, h) do { _Pragma("unroll") for (int n = 0; n < 2; ++n) _Pragma("unroll") for (int k = 0; k < 2; ++k) dst[n][k] = *(const PG8_LAS bf16x8*)(lds + PG8_SB(b, h) + boff + n * 2048 + k * 1024); } while (0)
#define PG8_MMA(ai, bj, At, Bt) do { __builtin_amdgcn_s_setprio(1); _Pragma("unroll") for (int m = 0; m < 4; ++m) _Pragma("unroll") for (int n = 0; n < 2; ++n) _Pragma("unroll") for (int k = 0; k < 2; ++k) \
        acc[ai][bj][m][n] = __builtin_amdgcn_mfma_f32_16x16x32_bf16(Bt[n][k], At[m][k], acc[ai][bj][m][n], 0, 0, 0); __builtin_amdgcn_s_setprio(0); } while (0)
#define PG8_WAIT_V(n) asm volatile("s_waitcnt vmcnt(" #n ")" ::: "memory")
#define PG8_WAIT_L(n) asm volatile("s_waitcnt lgkmcnt(" #n ")" ::: "memory")
#define PG8_BAR __builtin_amdgcn_s_barrier()
#define PG8_SCHED __builtin_amdgcn_sched_barrier(0)
    Unit cur, nxt; int ui = 0;
    if (!S.next(0, cur)) return;
    f32x4 acc[2][2][4][2];
#pragma unroll
    for (int a = 0; a < 2; ++a)
#pragma unroll
        for (int b = 0; b < 2; ++b)
#pragma unroll
            for (int m = 0; m < 4; ++m)
#pragma unroll
                for (int n = 0; n < 2; ++n) acc[a][b][m][n] = (f32x4){0.f, 0.f, 0.f, 0.f};
    bf16x8 At[4][2], B0[2][2], B1[2][2];
    typedef __fp16 h16x2 __attribute__((ext_vector_type(2)));
    h16x2 rrp[4];
    if constexpr (Epi::ROWSCALE) { float rr0[2][4]; row_rs8(E.ssq, cur.pm * BM + wr * 64 + fr, fq, rr0);
#pragma unroll
        for (int m = 0; m < 4; ++m) rrp[m] = __builtin_amdgcn_cvt_pkrtz(rr0[0][m], rr0[1][m]); }
    const char* cA = (const char*)gA + (size_t)cur.pm * tstepA + (size_t)cur.pn * acolB; const char* cB = (const char*)gB + (size_t)cur.pn * tstepB;
    S.a_ready(cur);
    if constexpr (SP2) {
        PG8_STAGE(PG8_SB(0, 0), cB, voffB); PG8_STAGE(PG8_SB(0, 1), cB + hstepB, voffB); PG8_STAGE(PG8_SA(0, 0), cA, voffA); PG8_STAGE(PG8_SA(0, 1), cA + hstepA, voffA);
        if (wr == 1) PG8_BAR;
        PG8_WAIT_V(2); PG8_BAR;
        PG8_STAGE(PG8_SB(1, 0), cB + kstep, voffB); PG8_STAGE(PG8_SA(1, 0), cA + kstep, voffA); PG8_STAGE(PG8_SB(1, 1), cB + hstepB + kstep, voffB);
        PG8_WAIT_V(6); PG8_BAR;
    } else {
        PG8_STAGE(PG8_SB(0, 0), cB, voffB); PG8_STAGE(PG8_SA(0, 0), cA, voffA); PG8_STAGE(PG8_SB(0, 1), cB + hstepB, voffB); PG8_STAGE(PG8_SA(0, 1), cA + hstepA, voffA);
        if (wr == 1) PG8_BAR;
        PG8_WAIT_V(4); PG8_BAR;
        PG8_STAGE(PG8_SB(1, 0), cB + kstep, voffB); PG8_STAGE(PG8_SA(1, 0), cA + kstep, voffA); PG8_STAGE(PG8_SB(1, 1), cB + hstepB + kstep, voffB);
        PG8_WAIT_V(6); PG8_BAR;
    }
    for (;;) {
        const bool has_next = S.next(ui + 1, nxt);
        const char* nA = has_next ? (const char*)gA + (size_t)nxt.pm * tstepA + (size_t)nxt.pn * acolB : cA; const char* nB = has_next ? (const char*)gB + (size_t)nxt.pn * tstepB : cB;
        for (int t = 0; t < nt; t += 2) {
            const bool last = (t == nt - 2);
            const char* a1 = cA + (size_t)(t + 1) * kstep;
            const char* a2 = last ? nA : cA + (size_t)(t + 2) * kstep; const char* b2 = last ? nB : cB + (size_t)(t + 2) * kstep;
            const char* a3 = a2 + kstep; const char* b3 = b2 + kstep;
            if (last && has_next) S.a_ready(nxt);
            if constexpr (SP2) {
            PG8_LDB(B0, 0, 0); PG8_LDB(B1, 0, 1); PG8_SCHED; PG8_LDA(At, 0, 0); PG8_STAGE(PG8_SA(1, 1), a1 + hstepA, voffA);
            PG8_WAIT_V(8); PG8_WAIT_L(0); PG8_BAR; PG8_MMA(0, 0, At, B0); PG8_MMA(0, 1, At, B1); PG8_BAR; PG8_SCHED;
            PG8_LDA(At, 0, 1); PG8_STAGE(PG8_SB(0, 0), b2, voffB); PG8_STAGE(PG8_SB(0, 1), b2 + hstepB, voffB); PG8_STAGE(PG8_SA(0, 0), a2, voffA);
            PG8_WAIT_V(8); PG8_WAIT_L(0); PG8_BAR; PG8_MMA(1, 0, At, B0); PG8_MMA(1, 1, At, B1); PG8_BAR; PG8_SCHED;
            PG8_LDB(B0, 1, 0); PG8_LDB(B1, 1, 1); PG8_SCHED; PG8_LDA(At, 1, 0); PG8_STAGE(PG8_SA(0, 1), a2 + hstepA, voffA);
            PG8_WAIT_V(8); PG8_WAIT_L(0); PG8_BAR; PG8_MMA(0, 0, At, B0); PG8_MMA(0, 1, At, B1); PG8_BAR; PG8_SCHED;
            PG8_LDA(At, 1, 1); PG8_STAGE(PG8_SB(1, 0), b3, voffB); PG8_STAGE(PG8_SB(1, 1), b3 + hstepB, voffB); PG8_STAGE(PG8_SA(1, 0), a3, voffA);
            PG8_WAIT_V(8); PG8_WAIT_L(0); PG8_BAR; PG8_MMA(1, 0, At, B0); PG8_MMA(1, 1, At, B1); PG8_BAR; PG8_SCHED;
            } else {
            PG8_LDB(B0, 0, 0); PG8_SCHED; PG8_LDA(At, 0, 0); PG8_STAGE(PG8_SA(1, 1), a1 + hstepA, voffA);
            PG8_WAIT_L(8); PG8_BAR; PG8_WAIT_L(0); PG8_MMA(0, 0, At, B0); PG8_BAR; PG8_SCHED;
            PG8_LDB(B1, 0, 1); PG8_STAGE(PG8_SB(0, 0), b2, voffB);
            PG8_BAR; PG8_WAIT_L(0); PG8_MMA(0, 1, At, B1); PG8_BAR;
            PG8_LDA(At, 0, 1); PG8_STAGE(PG8_SA(0, 0), a2, voffA);
            PG8_BAR; PG8_WAIT_L(0); PG8_MMA(1, 0, At, B0); PG8_BAR; PG8_SCHED;
            PG8_STAGE(PG8_SB(0, 1), b2 + hstepB, voffB);
            PG8_WAIT_V(6); PG8_BAR; PG8_MMA(1, 1, At, B1); PG8_BAR;
            PG8_LDB(B0, 1, 0); PG8_SCHED; PG8_LDA(At, 1, 0); PG8_STAGE(PG8_SA(0, 1), a2 + hstepA, voffA);
            PG8_WAIT_L(8); PG8_BAR; PG8_WAIT_L(0); PG8_MMA(0, 0, At, B0); PG8_BAR; PG8_SCHED;
            PG8_LDB(B1, 1, 1); PG8_STAGE(PG8_SB(1, 0), b3, voffB);
            PG8_BAR; PG8_WAIT_L(0); PG8_MMA(0, 1, At, B1); PG8_BAR;
            PG8_LDA(At, 1, 1); PG8_STAGE(PG8_SA(1, 0), a3, voffA);
            PG8_BAR; PG8_WAIT_L(0); PG8_MMA(1, 0, At, B0); PG8_BAR; PG8_SCHED;
            PG8_STAGE(PG8_SB(1, 1), b3 + hstepB, voffB);
            PG8_WAIT_V(6); PG8_BAR; PG8_MMA(1, 1, At, B1); PG8_BAR;
            }
        }
        if constexpr (ALIGN_EPI) { if (wr == 0) PG8_BAR; }
        if constexpr (!Epi::AFTER_DRAIN) {
            int fr_e = fr; asm volatile("" : "+v"(fr_e));
            if constexpr (Epi::ROWSCALE) { float rrs[2][4];
#pragma unroll
                for (int m = 0; m < 4; ++m) { unsigned pk = __builtin_bit_cast(unsigned, rrp[m]); asm volatile("" : "+v"(pk)); const h16x2 hp = __builtin_bit_cast(h16x2, pk); rrs[0][m] = (float)hp[0]; rrs[1][m] = (float)hp[1]; }
                E(acc, cur, wr, wc, fr_e, fq, rrs); } else E(acc, cur, wr, wc, fr_e, fq); S.done(cur); }
        if (!has_next) break;
#pragma unroll
        for (int a = 0; a < 2; ++a)
#pragma unroll
            for (int b = 0; b < 2; ++b)
#pragma unroll
                for (int m = 0; m < 4; ++m)
#pragma unroll
                    for (int n = 0; n < 2; ++n) acc[a][b][m][n] = (f32x4){0.f, 0.f, 0.f, 0.f};
        cur = nxt; cA = nA; cB = nB; ++ui;
        if constexpr (ALIGN_EPI) { if (wr == 1) PG8_BAR; }
    }
    PG8_WAIT_V(0);
    if constexpr (!ALIGN_EPI) { if (wr == 0) PG8_BAR; }
    PG8_BAR;
    if constexpr (Epi::AFTER_DRAIN) { E.fused(acc, cur, wr, wc, fr, fq, lds, wid, lane); S.done(cur); }
#undef PG8_SA
#undef PG8_SB
#undef PG8_STAGE
#undef PG8_LDA
#undef PG8_LDB
#undef PG8_MMA
#undef PG8_WAIT_V
#undef PG8_WAIT_L
#undef PG8_BAR
#undef PG8_SCHED
}
}

constexpr int NWAVES = 8;
constexpr int BATCH = 2, SEQ = 8192, D = 1024, FF = 2816, DEPTH = 4;
constexpr int M = BATCH * SEQ;
constexpr int N_PHASES = 2 + 6 * DEPTH;

constexpr size_t MiB = 1u << 20;
constexpr size_t WS_CTL = 0, CTL_ZERO_BYTES = 64 * 1024;
constexpr size_t WS_SSQ = 1 * MiB;
constexpr size_t WS_WCT = 2 * MiB;
constexpr size_t WS_WIN = 4 * MiB;
constexpr size_t WS_WCO = 16 * MiB;
constexpr size_t WS_WFO = 20 * MiB;
constexpr size_t WS_WGU = 24 * MiB;
constexpr size_t WS_WD  = 68 * MiB;
constexpr size_t WS_HB  = 90 * MiB;
constexpr size_t WS_ZY  = 122 * MiB;
constexpr size_t WS_ACT = 154 * MiB;
constexpr size_t WS_WC2 = 242 * MiB;
constexpr size_t WS_HALO = 250 * MiB;
constexpr size_t WS_END = 251 * MiB;
constexpr int CW_BAR = 4096;

constexpr int RING_OFF = 0, RING_BYTES = 131072;
constexpr int FFT_BYTES = 135424;
constexpr int LDSCTL_OFF = 139264, MISC_OFF = LDSCTL_OFF + 320;
constexpr int LDS_BYTES = 155648;

#define GAS __attribute__((address_space(1)))
#define LAS __attribute__((address_space(3)))
typedef unsigned short bf16;
typedef unsigned v4u __attribute__((ext_vector_type(4)));
typedef unsigned v2u __attribute__((ext_vector_type(2)));
typedef float f32x4 __attribute__((ext_vector_type(4)));
typedef float f32x16 __attribute__((ext_vector_type(16)));
typedef short bf16x8 __attribute__((ext_vector_type(8)));
typedef GAS unsigned gu32;
#define RLX_AGENT __ATOMIC_RELAXED, __HIP_MEMORY_SCOPE_AGENT
#define LDS_WAIT() asm volatile("s_waitcnt lgkmcnt(0)" ::: "memory")
#define VM_WAIT() asm volatile("s_waitcnt vmcnt(0)" ::: "memory")
__device__ __forceinline__ unsigned f2bf(float f) { unsigned u = __builtin_bit_cast(unsigned, f); return (u + 0x7fffu + ((u >> 16) & 1u)) >> 16; }
__device__ __forceinline__ unsigned pk2(float lo, float hi) { return f2bf(lo) | (f2bf(hi) << 16); }
__device__ __forceinline__ float bflo(unsigned w) { return __builtin_bit_cast(float, w << 16); }
__device__ __forceinline__ float bfhi(unsigned w) { return __builtin_bit_cast(float, w & 0xffff0000u); }
__device__ __forceinline__ v4u ld16_agent(const void* p) { const unsigned long long* q = (const unsigned long long*)p;
    const unsigned long long a = __hip_atomic_load(q, __ATOMIC_RELAXED, __HIP_MEMORY_SCOPE_AGENT), b = __hip_atomic_load(q + 1, __ATOMIC_RELAXED, __HIP_MEMORY_SCOPE_AGENT);
    return (v4u){(unsigned)a, (unsigned)(a >> 32), (unsigned)b, (unsigned)(b >> 32)}; }
#define MFMA32(a, b, c) __builtin_amdgcn_mfma_f32_32x32x16_bf16((a), (b), (c), 0, 0, 0)
__device__ __forceinline__ bf16x8 pack_step(const f32x16& x, int s) {
    v4u p; p.x = pg8::cvt_pk_bf16(x[8 * s], x[8 * s + 1]); p.y = pg8::cvt_pk_bf16(x[8 * s + 2], x[8 * s + 3]); p.z = pg8::cvt_pk_bf16(x[8 * s + 4], x[8 * s + 5]); p.w = pg8::cvt_pk_bf16(x[8 * s + 6], x[8 * s + 7]);
    return __builtin_bit_cast(bf16x8, p);
}

#define XB_TMO      128
#define XB_XCNT(j)  (256  + 64 * (j))
#define XB_XSUB(j)  (1280 + 64 * (j))
#define XB_XGEN(j)  (2304 + 64 * (j))
#define XB_TOP      3328
#define XB_TOPGEN   3392
#define XCD_BAR_WORDS 3456
#define XB_SPIN_CAP (1u << 18)

__device__ __forceinline__ unsigned xb_ld(unsigned* p)              { return __hip_atomic_load(p, __ATOMIC_RELAXED, __HIP_MEMORY_SCOPE_AGENT); }
__device__ __forceinline__ unsigned xb_add(unsigned* p, unsigned v) { return __hip_atomic_fetch_add(p, v, __ATOMIC_RELAXED, __HIP_MEMORY_SCOPE_AGENT); }
__device__ __forceinline__ unsigned xb_xcc_id() { return (unsigned)__builtin_amdgcn_s_getreg((3 << 11) | 20) & 0xFu; }
#define XB_SPIN(cond, bar) do { unsigned _sp = 0; while (cond) { __builtin_amdgcn_s_sleep(1); \
    if ((++_sp & 255u) == 0u) { if (xb_ld(&(bar)[XB_TMO])) break; if (_sp > XB_SPIN_CAP) { atomicAdd(&(bar)[XB_TMO], 1u); break; } } } } while (0)

struct XcdBarrier {
    unsigned* bar; unsigned x;
    volatile LAS unsigned* st;
};

__device__ __forceinline__ XcdBarrier xcd_barrier_post(unsigned* bar, volatile LAS unsigned* st) {
    XcdBarrier b; b.bar = bar; b.x = xb_xcc_id(); b.st = st;
    if (threadIdx.x == 0) (void)xb_add(&bar[XB_XCNT(b.x)], 1u);
    return b;
}
__device__ __forceinline__ void xcd_barrier_complete(unsigned* bar, unsigned x, unsigned& nloc, unsigned& nx) {
    const unsigned G = gridDim.x * gridDim.y * gridDim.z;
    unsigned sum, cnt, mine, sp = 0u;
    for (;;) {
        sum = 0u; cnt = 0u; mine = 0u;
#pragma unroll
        for (unsigned j = 0; j < 16; ++j) { const unsigned c = xb_ld(&bar[XB_XCNT(j)]); sum += c; cnt += (c > 0u) ? 1u : 0u; mine = (j == x) ? c : mine; }
        if (sum == G) break;
        __builtin_amdgcn_s_sleep(1);
        if ((++sp & 255u) == 0u) { if (xb_ld(&bar[XB_TMO])) break; if (sp > XB_SPIN_CAP) { atomicAdd(&bar[XB_TMO], 1u); break; } }
    }
    nloc = mine > 0u ? mine : 1u; nx = cnt > 0u ? cnt : 1u;
}

__device__ __forceinline__ void xcd_barrier(const XcdBarrier& b) {
    asm volatile("s_waitcnt vmcnt(0)" ::: "memory");
    __syncthreads();
    if (threadIdx.x == 0) {
        unsigned* bar = b.bar;
        __builtin_amdgcn_s_waitcnt(0);
        unsigned nloc = b.st[0], nx = b.st[1];
        if (nloc == 0u) { xcd_barrier_complete(bar, b.x, nloc, nx); b.st[0] = nloc; b.st[1] = nx; }
        const unsigned old = xb_add(&bar[XB_XSUB(b.x)], 1u);
        const unsigned gen = old / nloc;
        if (old + 1u == (gen + 1u) * nloc) {
            __builtin_amdgcn_fence(__ATOMIC_RELEASE, "agent");
            asm volatile("s_waitcnt vmcnt(0)" ::: "memory");
            const unsigned og = xb_add(&bar[XB_TOP], 1u);
            const unsigned tg = og / nx;
            if (og + 1u == (tg + 1u) * nx) xb_add(&bar[XB_TOPGEN], 1u);
            else XB_SPIN(xb_ld(&bar[XB_TOPGEN]) == tg, bar);
            __builtin_amdgcn_fence(__ATOMIC_ACQUIRE, "agent");
            xb_add(&bar[XB_XGEN(b.x)], 1u);
            asm volatile("s_waitcnt vmcnt(0)" ::: "memory");
        } else {
            XB_SPIN(xb_ld(&bar[XB_XGEN(b.x)]) == gen, bar);
            __builtin_amdgcn_fence(__ATOMIC_ACQUIRE, "agent");
            asm volatile("s_waitcnt vmcnt(0)" ::: "memory");
        }
    }
    __syncthreads();
}

struct Frame {
    LAS unsigned char* lds;
    volatile LAS unsigned* MISC;
    gu32* ctl;
    int tid, lane, wave;
    int vcu, G;
};
__device__ __forceinline__ float wave_sum(float v) {
#pragma unroll
    for (int o = 1; o < 64; o <<= 1) v += __shfl_xor(v, o);
    return v;
}

__device__ __forceinline__ void refresh(Frame& F) { int t = threadIdx.x; asm volatile("" : "+v"(t)); F.tid = t; F.lane = t & 63; F.wave = __builtin_amdgcn_readfirstlane(t >> 6); }
__device__ __forceinline__ void p0_transpose_item(const float* W, int ldw, int col0, int K, bf16* WT, int drow, const float* gain, LAS float* scr, int kb, int nb, int lane) {
    const int k0 = 64 * kb, n0 = 32 * nb;
    { float v[32]; const float* wp = W + (size_t)(k0 + (lane >> 5)) * ldw + col0 + n0 + (lane & 31);
#pragma unroll
      for (int i = 0; i < 32; ++i) v[i] = wp[(size_t)(2 * i) * ldw];
      if (gain) {
#pragma unroll
          for (int i = 0; i < 32; ++i) v[i] *= gain[k0 + 2 * i + (lane >> 5)]; }
#pragma unroll
      for (int i = 0; i < 32; ++i) scr[(2 * i + (lane >> 5)) * 33 + (lane & 31)] = v[i]; }
    LDS_WAIT(); asm volatile("" ::: "memory");
    const int c = lane & 7;
#pragma unroll
    for (int j = 0; j < 4; ++j) { const int n = (lane >> 3) + 8 * j; const LAS float* s = scr + (8 * c) * 33 + n;
        v4u o; o.x = pk2(s[0 * 33], s[1 * 33]); o.y = pk2(s[2 * 33], s[3 * 33]); o.z = pk2(s[4 * 33], s[5 * 33]); o.w = pk2(s[6 * 33], s[7 * 33]);
        *(GAS v4u*)(WT + (size_t)(drow + n) * K + k0 + 8 * c) = o; }
    LDS_WAIT(); asm volatile("" ::: "memory");
}
__device__ __forceinline__ int pair_row(int n, int half) { return 256 * (n >> 7) + 128 * half + (n & 127); }

struct In { const float *x, *conv_w_in, *conv_k, *conv_w_out, *four_w_out, *mix_g, *ffn_g, *w_gate, *w_up, *w_down, *final_g; };

__device__ __forceinline__ void convert_layer(Frame& F, const In& I, unsigned char* ws, int layer, int widx, int nw) {
    LAS float* scr = (LAS float*)(F.lds + RING_OFF + F.wave * 16384);
    bf16* Win = (bf16*)(ws + WS_WIN); bf16* Wco = (bf16*)(ws + WS_WCO); bf16* Wfo = (bf16*)(ws + WS_WFO); bf16* Wgu = (bf16*)(ws + WS_WGU); bf16* Wd = (bf16*)(ws + WS_WD);
    constexpr int I_CIN = 16 * 32, I_SQ = 16 * 32, I_GU = 16 * 88, I_DN = 44 * 32;
    const int j = layer >> 1, nmix = (layer & 1) ? I_SQ : 3 * I_CIN + I_SQ;
    for (int it = widx; it < nmix + 2 * I_GU + I_DN; it += nw) {
        int r = it;
        if (r < nmix) {
            if (layer & 1) { const int kb = r >> 5, nb = r & 31;
                p0_transpose_item(I.four_w_out + (size_t)j * 1024 * 1024, 1024, 0, 1024, Wfo + (size_t)j * 1024 * 1024, 32 * nb, nullptr, scr, kb, nb, F.lane); continue; }
            if (r < 3 * I_CIN) { const int part = r / I_CIN, idx = r % I_CIN, kb = idx >> 5, nb = idx & 31;
                const int col0 = part == 0 ? 1024 : (part == 1 ? 2048 : 0);
                const int blk = nb >> 2, tile = (blk >> 1) + 4 * (blk & 1);
                const int drow = part == 2 ? 2048 + 32 * nb : 256 * tile + 128 * part + ((32 * nb) & 127);
                p0_transpose_item(I.conv_w_in + (size_t)j * 1024 * 3072, 3072, col0, 1024, Win + (size_t)j * 3072 * 1024, drow, I.mix_g + layer * 1024, scr, kb, nb, F.lane); continue; }
            { const int idx = r - 3 * I_CIN, kb = idx >> 5, nb = idx & 31;
              p0_transpose_item(I.conv_w_out + (size_t)j * 1024 * 1024, 1024, 0, 1024, Wco + (size_t)j * 1024 * 1024, 32 * nb, nullptr, scr, kb, nb, F.lane); continue; }
        }
        r -= nmix;
        if (r < 2 * I_GU) { const int half = r / I_GU, idx = r % I_GU, kb = idx / 88, nb = idx % 88;
            p0_transpose_item((half ? I.w_up : I.w_gate) + (size_t)layer * 1024 * FF, FF, 0, 1024, Wgu + (size_t)layer * 2 * FF * 1024, pair_row(32 * nb, half), I.ffn_g + layer * 1024, scr, kb, nb, F.lane); }
        else { const int idx = r - 2 * I_GU, kb = idx >> 5, nb = idx & 31;
            p0_transpose_item(I.w_down + (size_t)layer * FF * 1024, 1024, 0, FF, Wd + (size_t)layer * 1024 * FF, 32 * nb, nullptr, scr, kb, nb, F.lane); }
    }
}
__device__ __forceinline__ void p0_prologue(Frame& F, const In& I, unsigned char* ws) {
    refresh(F);
    const int gw = F.vcu * NWAVES + F.wave, NGW = F.G * NWAVES;
    convert_layer(F, I, ws, 0, gw, NGW);
    bf16* HB = (bf16*)(ws + WS_HB); float* ssq = (float*)(ws + WS_SSQ);
    for (int m0 = 8 * gw; m0 < M; m0 += 8 * NGW) {
        float keep = 0.f;
#pragma unroll 4
        for (int j = 0; j < 8; ++j) { const int m = m0 + j;
            const GAS f32x4* xr = (const GAS f32x4*)(I.x + (size_t)m * D) + F.lane; GAS unsigned long long* o8 = (GAS unsigned long long*)(HB + (size_t)m * D) + F.lane; float s = 0.f;
#pragma unroll
            for (int jj = 0; jj < 4; ++jj) { const f32x4 v = xr[64 * jj]; s += (v.x * v.x + v.y * v.y) + (v.z * v.z + v.w * v.w);
                o8[64 * jj] = (unsigned long long)pg8::cvt_pk_bf16(v.x, v.y) | ((unsigned long long)pg8::cvt_pk_bf16(v.z, v.w) << 32); }
            s = wave_sum(s);
            if (F.lane == j) keep = s; }
#pragma unroll
        for (int pp = 0; pp < 2; ++pp) { const int p = 8 * pp + (F.lane >> 3); ssq[(size_t)p * M + m0 + (F.lane & 7)] = (p == 0) ? keep : 0.f; }
    }
    bf16* WC2 = (bf16*)(ws + WS_WC2);
    for (int e = (F.vcu * NWAVES * 64 + F.tid) * 2; e < 2 * 1024 * 256; e += F.G * NWAVES * 64 * 2) {
        const int kl = e & 255, n = (e >> 8) & 1023, jf = e >> 18, k = 256 * (n >> 8) + kl, ccg = n >> 1, g = ccg >> 6, cc = ccg & 63, ri = n & 1;
        unsigned w = 0u;
        if ((k >> 7) == g) { const float* gm = I.mix_g + (2 * jf + 1) * 1024; const int kk = k & 127; float v0, v1;
            if (cc == 0) { v0 = 1.f; v1 = ri ? -1.f : 1.f; }
            else { float s0, c0, s1, c1; sincospif((float)((kk * cc) & 127) * (1.0f / 64.0f), &s0, &c0); sincospif((float)(((kk + 1) * cc) & 127) * (1.0f / 64.0f), &s1, &c1);
                v0 = ri ? -s0 : c0; v1 = ri ? -s1 : c1; }
            w = pk2(v0 * gm[k], v1 * gm[k + 1]); }
        *(GAS unsigned*)(WC2 + e) = w;
    }
}

__device__ __forceinline__ void final_norm_phase(Frame& F, float* out, const bf16* HB, const float* ssq, const float* gf) {
    refresh(F);
    const int gw = F.vcu * NWAVES + F.wave, NGW = F.G * NWAVES;
    const GAS f32x4* gr = (const GAS f32x4*)gf + F.lane; const f32x4 g0 = gr[0], g1 = gr[64], g2 = gr[128], g3 = gr[192];
    for (int m0 = 4 * gw; m0 < M; m0 += 4 * NGW) {
        float sp[4]; v2u hw[4][4];
#pragma unroll
        for (int j = 0; j < 4; ++j) { const int m = m0 + j; sp[j] = F.lane < 16 ? pg8::ld_agent(ssq + (size_t)F.lane * M + m) : 0.f;
            const GAS v2u* hr = (const GAS v2u*)(HB + (size_t)m * D) + F.lane;
#pragma unroll
            for (int jj = 0; jj < 4; ++jj) hw[j][jj] = hr[64 * jj]; }
#pragma unroll
        for (int j = 0; j < 4; ++j) { const float r = __builtin_amdgcn_rsqf(wave_sum(sp[j]) * (1.0f / 1024.0f) + pg8::RMS_EPS);
            GAS f32x4* xr = (GAS f32x4*)(out + (size_t)(m0 + j) * D) + F.lane;
            xr[0]   = (f32x4){bflo(hw[j][0].x), bfhi(hw[j][0].x), bflo(hw[j][0].y), bfhi(hw[j][0].y)} * r * g0;
            xr[64]  = (f32x4){bflo(hw[j][1].x), bfhi(hw[j][1].x), bflo(hw[j][1].y), bfhi(hw[j][1].y)} * r * g1;
            xr[128] = (f32x4){bflo(hw[j][2].x), bfhi(hw[j][2].x), bflo(hw[j][2].y), bfhi(hw[j][2].y)} * r * g2;
            xr[192] = (f32x4){bflo(hw[j][3].x), bfhi(hw[j][3].x), bflo(hw[j][3].y), bfhi(hw[j][3].y)} * r * g3; }
    }
}

constexpr float C32[32] = {1.000000000e+00f, 9.807852804e-01f, 9.238795325e-01f, 8.314696123e-01f, 7.071067812e-01f, 5.555702330e-01f, 3.826834324e-01f, 1.950903220e-01f, 6.123233996e-17f, -1.950903220e-01f, -3.826834324e-01f, -5.555702330e-01f, -7.071067812e-01f, -8.314696123e-01f, -9.238795325e-01f, -9.807852804e-01f, -1.000000000e+00f, -9.807852804e-01f, -9.238795325e-01f, -8.314696123e-01f, -7.071067812e-01f, -5.555702330e-01f, -3.826834324e-01f, -1.950903220e-01f, -1.836970199e-16f, 1.950903220e-01f, 3.826834324e-01f, 5.555702330e-01f, 7.071067812e-01f, 8.314696123e-01f, 9.238795325e-01f, 9.807852804e-01f};
constexpr int BR4[16] = {0, 8, 4, 12, 2, 10, 6, 14, 1, 9, 5, 13, 3, 11, 7, 15};
constexpr int BR5[32] = {0, 16, 8, 24, 4, 20, 12, 28, 2, 18, 10, 26, 6, 22, 14, 30, 1, 17, 9, 25, 5, 21, 13, 29, 3, 19, 11, 27, 7, 23, 15, 31};
template <int N, int LOGN> __device__ __forceinline__ void fft_dif(float (&re)[N], float (&im)[N]) {
#pragma unroll
    for (int st = 0; st < LOGN; ++st) { const int len = N >> st, half = len >> 1, step = 32 / len;
#pragma unroll
        for (int base = 0; base < N; base += len)
#pragma unroll
            for (int j = 0; j < half; ++j) { const int a = base + j, b = a + half;
                const float ar = re[a], ai = im[a], br = re[b], bi = im[b]; re[a] = ar + br; im[a] = ai + bi;
                const float dr = ar - br, di = ai - bi; const int m = (j * step) & 31;
                if (m == 0) { re[b] = dr; im[b] = di; }
                else if (m == 8) { re[b] = di; im[b] = -dr; }
                else { const float wr = C32[m], ws = C32[(m + 24) & 31]; re[b] = dr * wr + di * ws; im[b] = di * wr - dr * ws; }
                asm("" : "+v"(re[a])); asm("" : "+v"(im[a])); asm("" : "+v"(re[b])); asm("" : "+v"(im[b])); } }
}
typedef float f32x2v __attribute__((ext_vector_type(2)));
template <int N, int LOGN> __device__ __forceinline__ void fft_dif2(f32x2v (&re)[N], f32x2v (&im)[N]) {
#pragma unroll
    for (int st = 0; st < LOGN; ++st) { const int len = N >> st, half = len >> 1, step = 32 / len;
#pragma unroll
        for (int base = 0; base < N; base += len)
#pragma unroll
            for (int j = 0; j < half; ++j) { const int a = base + j, b = a + half;
                const f32x2v ar = re[a], ai = im[a], br = re[b], bi = im[b]; re[a] = ar + br; im[a] = ai + bi;
                const f32x2v dr = ar - br, di = ai - bi; const int m = (j * step) & 31;
                if (m == 0) { re[b] = dr; im[b] = di; }
                else if (m == 8) { re[b] = di; im[b] = -dr; }
                else { const float wr = C32[m], ws = C32[(m + 24) & 31]; re[b] = dr * wr + di * ws; im[b] = di * wr - dr * ws; }
                asm("" : "+v"(re[a])); asm("" : "+v"(im[a])); asm("" : "+v"(re[b])); asm("" : "+v"(im[b])); } }
}
__device__ __forceinline__ int fft_off(int r) { return 16 * (r + (r >> 5)); }
template <int SB> __device__ __forceinline__ void pass16(LAS unsigned char* base, float wr, float wi) {
    f32x2v re[16], im[16];
#pragma unroll
    for (int q = 0; q < 16; ++q) { const v2u w = *(const LAS v2u*)(base + SB * q); re[q] = (f32x2v){bflo(w.x), bflo(w.y)}; im[q] = (f32x2v){bfhi(w.x), bfhi(w.y)}; }
    fft_dif2<16, 4>(re, im);
    float pr = 1.f, pi = 0.f;
#pragma unroll
    for (int k = 0; k < 16; ++k) { const f32x2v xr = re[BR4[k]], xi = im[BR4[k]], orr = xr * pr - xi * pi, oi = xr * pi + xi * pr;
        v2u o; o.x = pg8::cvt_pk_bf16(orr.x, oi.x); o.y = pg8::cvt_pk_bf16(orr.y, oi.y);
        *(LAS v2u*)(base + SB * k) = o;
        const float npr = pr * wr - pi * wi; pi = pr * wi + pi * wr; pr = npr; }
}
struct __attribute__((packed, aligned(2))) P8u { unsigned a, b; };
__device__ __forceinline__ int fft_slot(int k) { const int r = 512 * (k & 15) + 32 * ((k >> 4) & 15) + (k >> 8); return 16 * (r + (r >> 5) + (r >> 9)); }
__device__ __forceinline__ void fft_phase(Frame& F, const bf16* Yc, bf16* Y) {
    refresh(F);
    LAS unsigned char* buf = F.lds + RING_OFF; const int t = F.tid;
    for (int item = F.vcu; item < 256; item += F.G) {
        const int b = item >> 7, g = (item >> 4) & 7, q4 = item & 15;
        const bf16* src = Yc + ((size_t)(b * 128 + g * 16 + q4) * SEQ + t) * 8;
        LAS unsigned char* lt = buf + 16 * (t + (t >> 5));
#pragma unroll 1
        for (int i = 0; i < 16; i += 8) { v4u v[8];
#pragma unroll
            for (int j = 0; j < 8; ++j) v[j] = *(const GAS v4u*)(src + (size_t)(512 * (i + j)) * 8);
#pragma unroll
            for (int j = 0; j < 8; ++j) *(LAS v4u*)(lt + 8464 * (i + j)) = v[j]; }
        __syncthreads();
        { float sn, cs; sincospif((float)t * (1.0f / 4096.0f), &sn, &cs);
#pragma unroll 1
          for (int cp = 0; cp < 2; ++cp) pass16<8464>(lt + 8 * cp, cs, -sn); }
        __syncthreads();
        { const int ka = t >> 5, sc = t & 31; float sn, cs; sincospif((float)sc * (1.0f / 256.0f), &sn, &cs);
          LAS unsigned char* l2 = buf + 16 * (529 * ka + sc);
#pragma unroll 1
          for (int cp = 0; cp < 2; ++cp) pass16<528>(l2 + 8 * cp, cs, -sn); }
        __syncthreads();
        { const int col = t >> 1; LAS unsigned char* l3 = buf + 16 * (529 * (col >> 4) + 33 * (col & 15)) + 8 * (t & 1);
#pragma unroll 1
          for (int c = 0; c < 2; ++c) { float re[32], im[32];
#pragma unroll
              for (int qq = 0; qq < 32; ++qq) { const unsigned w = *(const LAS unsigned*)(l3 + 4 * c + 16 * qq); re[qq] = bflo(w); im[qq] = bfhi(w); }
              fft_dif<32, 5>(re, im);
#pragma unroll
              for (int k = 0; k < 32; ++k) *(LAS unsigned*)(l3 + 4 * c + 16 * k) = pg8::cvt_pk_bf16(re[BR5[k]], im[BR5[k]]); } }
        __syncthreads();
        bf16* dst = Y + ((size_t)b * SEQ) * 1024 + 128 * g;
        const float sc1 = 1.0f / 1024.0f;
#pragma unroll 2
        for (int i = 0; i < 16; ++i) { const int k = t + 512 * i, km = (SEQ - k) & (SEQ - 1);
            const v4u v = *(const LAS v4u*)(buf + fft_slot(k)), w = *(const LAS v4u*)(buf + fft_slot(km));
            float d0 = bflo(v.x) * sc1, m0 = bflo(w.x) * sc1;
            if (q4 == 0) { d0 = 0.5f * sc1 * (bflo(v.x) + bflo(w.x)); m0 = 0.5f * sc1 * (bfhi(v.x) + bfhi(w.x)); }
            bf16* row = dst + (size_t)k * 1024;
            v2u o; o.x = pg8::cvt_pk_bf16(d0, bflo(v.y) * sc1); o.y = pg8::cvt_pk_bf16(bflo(v.z) * sc1, bflo(v.w) * sc1);
            *(GAS v2u*)(row + 4 * q4) = o;
            const unsigned m12 = pg8::cvt_pk_bf16(bflo(w.z) * sc1, bflo(w.y) * sc1);
            const unsigned m3 = pg8::cvt_pk_bf16(bflo(w.w) * sc1, 0.f) & 0xffffu, mz = pg8::cvt_pk_bf16(m0, 0.f) & 0xffffu;
            if (q4 != 0) { P8u o2; o2.a = m3 | (m12 << 16); o2.b = (m12 >> 16) | (mz << 16); *(P8u*)(row + 125 - 4 * q4) = o2; }
            else { row[125] = (bf16)m3; *(GAS unsigned*)(row + 126) = m12; row[64] = (bf16)mz; }
        }
        __syncthreads();
    }
}
__device__ __forceinline__ void conv_halo_fix(int pm, const bf16* U, const bf16* HZ, const bf16* HBg, const float* taps, bf16* Z) {
    int t_l = threadIdx.x; asm volatile("" : "+v"(t_l));
    const int t = t_l, side = t >> 8, c4 = (t & 255) * 4, row = side ? 256 * pm + 255 : 256 * pm, sq = row & (SEQ - 1);
    if (side ? (sq != SEQ - 1) : (sq != 0)) {
        const size_t ho = (size_t)(2 * pm + side) * 1024 + c4; const int nrow = side ? row + 1 : row - 1;
        const v2u zp = *(const GAS v2u*)(HZ + ho), b = *(const GAS v2u*)(HBg + ho), un = *(const GAS v2u*)(U + (size_t)nrow * 1024 + c4); const f32x4 k = *(const GAS f32x4*)(taps + (side ? 2048 : 0) + c4);
        v2u o; o.x = pg8::cvt_pk_bf16(bflo(zp.x) + bflo(b.x) * k[0] * bflo(un.x), bfhi(zp.x) + bfhi(b.x) * k[1] * bfhi(un.x));
        o.y = pg8::cvt_pk_bf16(bflo(zp.y) + bflo(b.y) * k[2] * bflo(un.y), bfhi(zp.y) + bfhi(b.y) * k[3] * bfhi(un.y));
        *(GAS v2u*)(Z + (size_t)row * 1024 + c4) = o;
    }
    asm volatile("s_waitcnt vmcnt(0)" ::: "memory");
    __syncthreads();
}
struct Args { const float* in[11]; float* out; unsigned char* ws; int ph_lo, ph_hi; };
__global__ void __launch_bounds__(NWAVES * 64, 2) mk_fwd(Args args) {
    extern __shared__ __attribute__((aligned(16))) unsigned char lds[];
    Frame F;
    F.lds = (LAS unsigned char*)lds;
    F.MISC = (volatile LAS unsigned*)(F.lds + MISC_OFF);
    F.tid = threadIdx.x; F.lane = F.tid & 63; F.wave = __builtin_amdgcn_readfirstlane(F.tid >> 6);
    F.G = gridDim.x; { const int bx = blockIdx.x; F.vcu = (F.G % 8 == 0) ? (bx % 8) * (F.G / 8) + bx / 8 : bx; }
    unsigned char* ws = args.ws;
    F.ctl = (gu32*)(ws + WS_CTL);
    In I; I.x = args.in[0]; I.conv_w_in = args.in[1]; I.conv_k = args.in[2]; I.conv_w_out = args.in[3]; I.four_w_out = args.in[4]; I.mix_g = args.in[5]; I.ffn_g = args.in[6];
    I.w_gate = args.in[7]; I.w_up = args.in[8]; I.w_down = args.in[9]; I.final_g = args.in[10];
    for (int u = F.tid; u < (LDS_BYTES - LDSCTL_OFF) / 4; u += NWAVES * 64) ((LAS unsigned*)(F.lds + LDSCTL_OFF))[u] = 0u;
    __syncthreads();
    XcdBarrier bar; bar.bar = (unsigned*)(F.ctl + CW_BAR); bar.x = 0; bar.st = nullptr;
    if (!MK_PER_PHASE) bar = xcd_barrier_post((unsigned*)(F.ctl + CW_BAR), F.MISC + 8);
    const int lo = args.ph_lo, hi = args.ph_hi;
#define IN(k) (lo <= (k) && (k) < hi)
#define SEAM(k) do { if (!MK_PER_PHASE && IN(k) && IN((k) + 1)) xcd_barrier(bar); } while (0)
    float* const hout = args.out;
    bf16* const HB = (bf16*)(ws + WS_HB); bf16* const ZY = (bf16*)(ws + WS_ZY); bf16* const ACT = (bf16*)(ws + WS_ACT);
    bf16* const UU = ACT + (size_t)M * 1024;
    float* const ssq = (float*)(ws + WS_SSQ);

    if (IN(0)) p0_prologue(F, I, ws);
    SEAM(0);
#pragma unroll 1
    for (int i = 0; i < DEPTH; ++i) {
        const int p = 1 + 6 * i, j = i >> 1;
        bf16* const HALO = (bf16*)(ws + WS_HALO);
        bf16* const YC = ACT;
        if ((i & 1) == 0) {
            if (IN(p)) { pg8::Gemm g{HB, (const bf16*)(ws + WS_WIN) + (size_t)j * 3072 * 1024, M, 3072, D}; pg8::StaticOrder S; S.init(M, 3072, F.G, (int)blockIdx.x);
                pg8::EpiConvFused E{UU, ZY, HALO, HALO + 128 * 1024, ssq, I.conv_k + (size_t)j * 3 * 1024};
                pg8::gemm_phase<pg8::EpiConvFused, pg8::StaticOrder, true, true>(F.lds + RING_OFF, g, S, E); }
            if (!MK_PER_PHASE && IN(p) && IN(p + 3)) xcd_barrier(bar);
        } else {
            if (IN(p)) { pg8::Gemm g{HB, (const bf16*)(ws + WS_WC2) + (size_t)j * 1024 * 256, M, 1024, 256};     pg8::StaticOrder S; S.init(M, 1024, F.G, (int)blockIdx.x);
                pg8::EpiScale E{YC, 1024, ssq};
                pg8::gemm_phase<pg8::EpiScale, pg8::StaticOrder, true, true, 1024, 256>(F.lds + RING_OFF, g, S, E); }
            SEAM(p);
            if (IN(p + 1)) fft_phase(F, YC, ZY);
            if (!MK_PER_PHASE && IN(p + 1) && IN(p + 3)) xcd_barrier(bar);
        }
        if (IN(p + 3)) { const bf16* Wt = (i & 1) ? (const bf16*)(ws + WS_WFO) + (size_t)j * 1024 * 1024 : (const bf16*)(ws + WS_WCO) + (size_t)j * 1024 * 1024;
            pg8::Gemm g{ZY, Wt, M, D, D}; pg8::StaticOrder S; S.init(M, D, F.G, (int)blockIdx.x);
            if ((i & 1) == 0) { pg8::Unit uu; for (int k = 0; S.next(k, uu); ++k) conv_halo_fix(uu.pm, UU, HALO, HALO + 128 * 1024, I.conv_k + (size_t)j * 3 * 1024, ZY); }
            pg8::EpiResid E{HB, ssq};
            pg8::gemm_phase<pg8::EpiResid, pg8::StaticOrder, true, true>(F.lds + RING_OFF, g, S, E); }
        SEAM(p + 3);
        if (IN(p + 4)) { pg8::Gemm g{HB, (const bf16*)(ws + WS_WGU) + (size_t)i * 2 * FF * 1024, M, 2 * FF, D}; pg8::StaticOrder S; S.init(M, 2 * FF, F.G, (int)blockIdx.x);
            pg8::EpiSwiGLU E{ACT, FF, ssq};
            pg8::gemm_phase<pg8::EpiSwiGLU, pg8::StaticOrder, true, true>(F.lds + RING_OFF, g, S, E);
            if (i + 1 < DEPTH) {
                const int nfull = S.nwg % F.G, c = (int)blockIdx.x;
                if (nfull == 0) { refresh(F); convert_layer(F, I, ws, i + 1, c * NWAVES + F.wave, F.G * NWAVES); }
                else if (c >= nfull) { refresh(F); convert_layer(F, I, ws, i + 1, (c - nfull) * NWAVES + F.wave, (F.G - nfull) * NWAVES); } } }
        SEAM(p + 4);
        if (IN(p + 5)) { pg8::Gemm g{ACT, (const bf16*)(ws + WS_WD) + (size_t)i * 1024 * FF, M, D, FF}; pg8::StaticOrder S; S.init(M, D, F.G, (int)blockIdx.x);
            pg8::EpiResid E{HB, ssq};
            pg8::gemm_phase<pg8::EpiResid, pg8::StaticOrder, true, true>(F.lds + RING_OFF, g, S, E); }
        SEAM(p + 5);
    }
    if (IN(N_PHASES - 1)) final_norm_phase(F, hout, HB, ssq, I.final_g);
#undef IN
#undef SEAM
}

extern "C" void kernel_launch(void* const* d_in, const int* in_sizes, int n_in, void* d_out, int out_size, void* d_ws, size_t ws_size, hipStream_t stream) {
    static int grid = 0;
    if (grid == 0) {
        if (n_in != 11 || in_sizes[0] != M * D || out_size != M * D || ws_size < WS_END) { fprintf(stderr, "kernel_launch: unexpected shapes (n_in %d, in0 %d, out %d, ws %zu); nothing launched\n", n_in, n_in > 0 ? in_sizes[0] : -1, out_size, ws_size); grid = -1; return; }
        int dev = 0, cus = 0, per_cu = 0;
        if (hipGetDevice(&dev) != hipSuccess || hipDeviceGetAttribute(&cus, hipDeviceAttributeMultiprocessorCount, dev) != hipSuccess) { fprintf(stderr, "kernel_launch: device query failed\n"); grid = -1; return; }
        if (hipFuncSetAttribute((const void*)mk_fwd, hipFuncAttributeMaxDynamicSharedMemorySize, LDS_BYTES) != hipSuccess) { fprintf(stderr, "kernel_launch: hipFuncSetAttribute failed\n"); grid = -1; return; }
        if (hipOccupancyMaxActiveBlocksPerMultiprocessor(&per_cu, (const void*)mk_fwd, NWAVES * 64, LDS_BYTES) != hipSuccess || per_cu < 1)
            fprintf(stderr, "kernel_launch: note: occupancy query reports %d workgroups per CU\n", per_cu);
        (void)hipGetLastError();
        grid = cus;
        if (grid != 256) { fprintf(stderr, "kernel_launch: this kernel's fused conv mixer needs exactly 256 workgroups (one per CU of a 256-CU device); found %d CUs; nothing launched\n", cus); grid = -1; return; }
    }
    if (grid < 0) return;
    if (hipMemsetAsync((char*)d_ws + WS_CTL, 0, CTL_ZERO_BYTES, stream) != hipSuccess) { fprintf(stderr, "kernel_launch: hipMemsetAsync failed\n"); return; }
    Args a{};
    for (int i = 0; i < 11; ++i) a.in[i] = (const float*)d_in[i];
    a.out = (float*)d_out; a.ws = (unsigned char*)d_ws;
#if MK_PER_PHASE
    for (int ph = 0; ph < N_PHASES; ++ph) { a.ph_lo = ph; a.ph_hi = ph + 1;
        hipLaunchKernelGGL(mk_fwd, dim3(grid), dim3(NWAVES * 64), LDS_BYTES, stream, a); }
#else
    a.ph_lo = 0; a.ph_hi = N_PHASES;
    hipLaunchKernelGGL(mk_fwd, dim3(grid), dim3(NWAVES * 64), LDS_BYTES, stream, a);
#endif
    const hipError_t le = hipPeekAtLastError();
    if (le != hipSuccess) fprintf(stderr, "kernel_launch: launch failed: %s\n", hipGetErrorName(le));
}
```
